# Optimizing an MI355X kernel written in HIP

```python
import math
import jax, jax.numpy as jnp
from jax import lax
import numpy as np

D_MODEL = 1024
BATCH = 8
SEQ = 2048
DEPTH = 1

SSM_GROUP_CH = 16
SSM_WIDTH = D_MODEL // 2
SSM_GROUPS = SSM_WIDTH // SSM_GROUP_CH
SSM_STATE = 64
DT_MIN = 1e-3
DT_MAX = 1e-1
GMLP_WIDTH = D_MODEL // 2
GMLP_HEADS = 8
GMLP_HEAD_DIM = GMLP_WIDTH // GMLP_HEADS
CHUNK = 128
PROJ_WIDTH = SSM_WIDTH + 2 * GMLP_WIDTH + 2 * D_MODEL
N_EXPERTS = 32
TOP_K = 4
D_EXPERT = D_MODEL
SWIGLU_LIMIT = 7.0
SWIGLU_ALPHA = 1.702
ROUTE_BLOCK = 128
N_MOD = 6
EPS = 1e-6

kernel_name = 'hybrid_s5_gmlp_moe_block'


def rms_norm(x, g):
    xf = x.astype(jnp.float32)
    y = xf * lax.rsqrt(jnp.mean(xf * xf, axis=-1, keepdims=True) + EPS)
    return (y * g.astype(jnp.float32)).astype(x.dtype)


def modulate(h, shift, scale):
    return h * (1 + scale[:, None, :]) + shift[:, None, :]


def s5_branch(u, a_re, a_im, log_dt, b_re, b_im, c_re, c_im, d_skip, glu_w, glu_b):
    bsz, seq, _ = u.shape
    uf = u.astype(jnp.float32).reshape(bsz, seq, SSM_GROUPS, SSM_GROUP_CH)
    lam = lax.complex(a_re.astype(jnp.float32), a_im.astype(jnp.float32))
    dt = jnp.exp(log_dt.astype(jnp.float32))[:, None]
    lam_bar = jnp.exp(lam * dt)
    b = lax.complex(b_re.astype(jnp.float32), b_im.astype(jnp.float32))
    b_bar = ((lam_bar - 1) / lam)[..., None] * b
    bu = jnp.einsum('bsgh,gph->bsgp', uf, b_bar)
    decay = jnp.broadcast_to(lam_bar, bu.shape)

    def combine(left, right):
        a_l, s_l = left
        a_r, s_r = right
        return a_r * a_l, a_r * s_l + s_r

    _, states = lax.associative_scan(combine, (decay, bu), axis=1)
    cm = lax.complex(c_re.astype(jnp.float32), c_im.astype(jnp.float32))
    y = jnp.einsum('bsgp,ghp->bsgh', states, cm).real
    y = y + d_skip.astype(jnp.float32).reshape(SSM_GROUPS, SSM_GROUP_CH) * uf
    y = y.reshape(bsz, seq, SSM_WIDTH)
    z = jax.nn.gelu(y)
    out = z * jax.nn.sigmoid(z @ glu_w.astype(jnp.float32) + glu_b.astype(jnp.float32))
    return out.astype(u.dtype)


def gmlp_branch(zuv, ln_g, ln_b, ws, bs):
    bsz, seq, _ = zuv.shape
    z = jax.nn.gelu(zuv)
    u, v = jnp.split(z, 2, axis=-1)
    vf = v.astype(jnp.float32)
    mu = jnp.mean(vf, axis=-1, keepdims=True)
    var = jnp.mean(jnp.square(vf - mu), axis=-1, keepdims=True)
    vn = (vf - mu) * lax.rsqrt(var + EPS) * ln_g.astype(jnp.float32) + ln_b.astype(jnp.float32)
    vn = vn.reshape(bsz, seq // CHUNK, CHUNK, GMLP_HEADS, GMLP_HEAD_DIM)
    causal = jnp.tril(jnp.ones((CHUNK, CHUNK), jnp.float32))
    w = ws.astype(jnp.float32) * causal
    mixed = jnp.einsum('hts,bnshc->bnthc', w, vn) + bs.astype(jnp.float32).T[:, :, None]
    return u * mixed.reshape(bsz, seq, GMLP_WIDTH).astype(u.dtype)


def moe(h, router_w, router_b, w_in, b_in, w_out, b_out):
    bsz, seq, d = h.shape
    tok = h.reshape(-1, d)
    n_tok = tok.shape[0]
    logits = (tok @ router_w + router_b).astype(jnp.float32)
    top_val, top_idx = lax.top_k(logits, TOP_K)
    weights = jax.nn.softmax(top_val, axis=-1)
    n_assign = n_tok * TOP_K
    flat_e = top_idx.reshape(-1)
    flat_tok = jnp.repeat(jnp.arange(n_tok, dtype=jnp.int32), TOP_K)
    flat_w = weights.reshape(-1)
    order = jnp.argsort(flat_e)
    sorted_e = flat_e[order]
    counts = jnp.bincount(flat_e, length=N_EXPERTS)
    start = jnp.cumsum(counts) - counts
    padded = (counts + ROUTE_BLOCK - 1) // ROUTE_BLOCK * ROUTE_BLOCK
    pad_end = jnp.cumsum(padded)
    pad_start = pad_end - padded
    rank = jnp.arange(n_assign, dtype=jnp.int32) - start[sorted_e]
    dest = pad_start[sorted_e] + rank
    n_rows = (n_assign + ROUTE_BLOCK - 1) // ROUTE_BLOCK * ROUTE_BLOCK + N_EXPERTS * ROUTE_BLOCK
    n_blocks = n_rows // ROUTE_BLOCK
    row_tok = jnp.zeros((n_rows,), jnp.int32).at[dest].set(flat_tok[order])
    row_w = jnp.zeros((n_rows,), jnp.float32).at[dest].set(flat_w[order])
    blk_start = jnp.arange(n_blocks, dtype=jnp.int32) * ROUTE_BLOCK
    blk_e = jnp.minimum(jnp.searchsorted(pad_end, blk_start, side='right'), N_EXPERTS - 1)

    def expert_block(args):
        rows, e = args
        xb = tok[rows]
        gu = xb @ w_in[e] + b_in[e]
        gate, up = gu[:, :D_EXPERT], gu[:, D_EXPERT:]
        gate = jnp.minimum(gate, SWIGLU_LIMIT)
        up = jnp.clip(up, -SWIGLU_LIMIT, SWIGLU_LIMIT)
        act = (up + 1) * (gate * jax.nn.sigmoid(SWIGLU_ALPHA * gate))
        return act @ w_out[e] + b_out[e]

    ys = lax.map(expert_block, (row_tok.reshape(n_blocks, ROUTE_BLOCK), blk_e))
    ys = ys.reshape(n_rows, d)
    ys = ys * row_w[:, None].astype(ys.dtype)
    out = jnp.zeros_like(tok).at[row_tok].add(ys.astype(tok.dtype))
    return out.reshape(bsz, seq, d)


def setup_inputs(seed: int = 0) -> dict:
    key = jax.random.key(seed)
    ks = jax.random.split(key, 32)
    f32 = jnp.float32
    nrm = lambda k, shape, s: jax.random.normal(k, shape, f32) * s
    L, D, G, P, H = DEPTH, D_MODEL, SSM_GROUPS, SSM_STATE, SSM_GROUP_CH
    n_idx = jnp.arange(P, dtype=f32)
    return {
        'x': nrm(ks[0], (BATCH, SEQ, D), 1.0),
        'c': nrm(ks[1], (BATCH, D), 1.0),
        'ada_w': nrm(ks[2], (L, D, N_MOD * D), 0.5 * D ** -0.5),
        'ada_b': nrm(ks[3], (L, N_MOD * D), 0.02),
        'norm1_g': 1.0 + nrm(ks[4], (L, D), 0.02),
        'w_in': nrm(ks[5], (L, D, PROJ_WIDTH), D ** -0.5),
        'ssm_a_re': -0.5 + nrm(ks[6], (L, G, P), 0.01),
        'ssm_a_im': math.pi * n_idx + nrm(ks[7], (L, G, P), 0.01),
        'ssm_log_dt': jax.random.uniform(ks[8], (L, G), f32, math.log(DT_MIN), math.log(DT_MAX)),
        'ssm_b_re': nrm(ks[9], (L, G, P, H), (2 * H) ** -0.5),
        'ssm_b_im': nrm(ks[10], (L, G, P, H), (2 * H) ** -0.5),
        'ssm_c_re': nrm(ks[11], (L, G, H, P), P ** -0.5),
        'ssm_c_im': nrm(ks[12], (L, G, H, P), P ** -0.5),
        'ssm_d': nrm(ks[13], (L, SSM_WIDTH), 1.0),
        'ssm_glu_w': nrm(ks[14], (L, SSM_WIDTH, SSM_WIDTH), SSM_WIDTH ** -0.5),
        'ssm_glu_b': nrm(ks[15], (L, SSM_WIDTH), 0.02),
        'w_branch_a': nrm(ks[16], (L, SSM_WIDTH, D), SSM_WIDTH ** -0.5),
        'gmlp_ln_g': 1.0 + nrm(ks[17], (L, GMLP_WIDTH), 0.02),
        'gmlp_ln_b': nrm(ks[18], (L, GMLP_WIDTH), 0.02),
        'gmlp_ws': nrm(ks[19], (L, GMLP_HEADS, CHUNK, CHUNK), CHUNK ** -0.5),
        'gmlp_bs': 1.0 + nrm(ks[20], (L, GMLP_HEADS, CHUNK), 0.02),
        'w_branch_b': nrm(ks[21], (L, GMLP_WIDTH, D), GMLP_WIDTH ** -0.5),
        'w_out': nrm(ks[22], (L, D, D), D ** -0.5),
        'norm2_g': 1.0 + nrm(ks[23], (L, D), 0.02),
        'router_w': nrm(ks[24], (L, D, N_EXPERTS), D ** -0.5),
        'router_b': nrm(ks[25], (L, N_EXPERTS), 0.01),
        'moe_w_in': nrm(ks[26], (L, N_EXPERTS, D, 2 * D_EXPERT), D ** -0.5),
        'moe_b_in': nrm(ks[27], (L, N_EXPERTS, 2 * D_EXPERT), 0.02),
        'moe_w_out': nrm(ks[28], (L, N_EXPERTS, D_EXPERT, D), D_EXPERT ** -0.5),
        'moe_b_out': nrm(ks[29], (L, N_EXPERTS, D), 0.02),
        'final_g': 1.0 + nrm(ks[30], (D,), 0.02),
    }


def reference(x, c, ada_w, ada_b, norm1_g, w_in, ssm_a_re, ssm_a_im, ssm_log_dt, ssm_b_re, ssm_b_im, ssm_c_re, ssm_c_im, ssm_d, ssm_glu_w, ssm_glu_b, w_branch_a, gmlp_ln_g, gmlp_ln_b, gmlp_ws, gmlp_bs, w_branch_b, w_out, norm2_g, router_w, router_b, moe_w_in, moe_b_in, moe_w_out, moe_b_out, final_g):
    split_at = [SSM_WIDTH, SSM_WIDTH + 2 * GMLP_WIDTH, SSM_WIDTH + 2 * GMLP_WIDTH + D_MODEL]
    for layer in range(DEPTH):
        mod = jax.nn.silu(c) @ ada_w[layer] + ada_b[layer]
        shift1, scale1, gate1, shift2, scale2, gate2 = jnp.split(mod, N_MOD, axis=-1)
        h = modulate(rms_norm(x, norm1_g[layer]), shift1, scale1)
        proj = h @ w_in[layer]
        u_ssm, zuv, g_a, g_b = jnp.split(proj, split_at, axis=-1)
        y_a = s5_branch(u_ssm, ssm_a_re[layer], ssm_a_im[layer], ssm_log_dt[layer], ssm_b_re[layer], ssm_b_im[layer], ssm_c_re[layer], ssm_c_im[layer], ssm_d[layer], ssm_glu_w[layer], ssm_glu_b[layer]) @ w_branch_a[layer]
        y_b = gmlp_branch(zuv, gmlp_ln_g[layer], gmlp_ln_b[layer], gmlp_ws[layer], gmlp_bs[layer]) @ w_branch_b[layer]
        merged = jax.nn.sigmoid(g_a) * y_a + jax.nn.sigmoid(g_b) * y_b
        x = x + gate1[:, None, :] * (merged @ w_out[layer])
        h = modulate(rms_norm(x, norm2_g[layer]), shift2, scale2)
        x = x + gate2[:, None, :] * moe(h, router_w[layer], router_b[layer], moe_w_in[layer], moe_b_in[layer], moe_w_out[layer], moe_b_out[layer])
    return rms_norm(x, final_g)
```

```cpp
#include <hip/hip_runtime.h>
#include <cstdio>
#include <cstdint>
namespace pg8 {
#define PG8_LAS __attribute__((address_space(3)))
typedef unsigned short bf16_t;
typedef short bf16x8 __attribute__((ext_vector_type(8)));
typedef float f32x4 __attribute__((ext_vector_type(4)));
typedef float f32x2 __attribute__((ext_vector_type(2)));
typedef unsigned u32x4 __attribute__((ext_vector_type(4)));
typedef unsigned u32x2 __attribute__((ext_vector_type(2)));
constexpr int BM = 256, BK = 64, HALF = 128, HTB = HALF * BK * 2  , STAGE_BYTES = 8 * HTB, NXCD = 8, WGM = 8;
constexpr int VN_SLOT_OFF = STAGE_BYTES + 1024;

__host__ __device__ __forceinline__ int lds_byte(int r, int c) { const int st = (r >> 4) * 2 + (c >> 5), rr = r & 15, cc = c & 31, ob = rr * 64 + cc * 2; return st * 1024 + (ob ^ (((ob >> 9) & 1) << 5)); }
__host__ __device__ __forceinline__ void stage_rc(int b, int& R, int& C) { const int st = b / 1024, sb = b % 1024, swz = sb ^ (((sb >> 9) & 1) << 5); R = (st >> 1) * 16 + swz / 64; C = (st & 1) * 32 + (swz % 64) / 2; }
__host__ __device__ __forceinline__ int perm32(int rho) { const int n = rho >> 4, i = rho & 15; return 8 * (i >> 2) + 4 * n + (i & 3); }

struct Unit { int pm, pn, aux; const char* abase; const char* b0; const char* b1; };

__device__ __forceinline__ unsigned cvt_pk_bf16(float lo, float hi) { unsigned r; asm volatile("v_cvt_pk_bf16_f32 %0, %1, %2" : "=v"(r) : "v"(lo), "v"(hi)); return r; }

template <class Epi, class Sched>
__device__ __forceinline__ void gemm_phase(PG8_LAS unsigned char* lds, const int K, const Sched& S, const Epi& E) {
    const int tid = threadIdx.x, wid = __builtin_amdgcn_readfirstlane(tid >> 6), lane = tid & 63, wr = wid >> 2, wc = wid & 3, fr = lane & 15, fq = lane >> 4;
    const int nt = K / BK;
    int Rp[2], Cp[2]; unsigned voffB[2];
#pragma unroll
    for (int i = 0; i < 2; ++i) { int R, C; stage_rc(tid * 16 + i * 8192, R, C); Rp[i] = R; Cp[i] = C; const int Rb = Epi::PERM ? ((R & ~31) + perm32(R & 31)) : R; voffB[i] = (unsigned)(Rb * K + C) * 2u; }
    const size_t kstep = (size_t)(BK * 2);
    const unsigned ldsw = (unsigned)wid * 1024u;
    const int aoff = lds_byte(wr * 64 + fr, fq * 8), boff = lds_byte(wc * 32 + fr, fq * 8);
#define PG8_SA(b, h) (((b) * 2 + (h)) * HTB)
#define PG8_SB(b, h) ((4 + (b) * 2 + (h)) * HTB)
#define PG8_STAGE(bufoff, gbase, voff) do { _Pragma("unroll") for (int _i = 0; _i < 2; ++_i) \
        __builtin_amdgcn_global_load_lds((const unsigned*)((const char*)(gbase) + (voff)[_i]), (PG8_LAS unsigned*)(lds + (bufoff) + ldsw + _i * 8192), 16, 0, 0); } while (0)
#define PG8_LDA(dst, b, h) do { _Pragma("unroll") for (int m = 0; m < 4; ++m) _Pragma("unroll") for (int k = 0; k < 2; ++k) dst[m][k] = *(const PG8_LAS bf16x8*)(lds + PG8_SA(b, h) + aoff + m * 2048 + k * 1024); } while (0)
#define PG8_LDB(dst, b, h) do { _Pragma("unroll") for (int n = 0; n < 2; ++n) _Pragma("unroll") for (int k = 0; k < 2; ++k) dst[n][k] = *(const PG8_LAS bf16x8*)(lds + PG8_SB(b, h) + boff + n * 2048 + k * 1024); } while (0)
#define PG8_MMA(ai, bj, At, Bt) do { __builtin_amdgcn_s_setprio(1); _Pragma("unroll") for (int m = 0; m < 4; ++m) _Pragma("unroll") for (int n = 0; n < 2; ++n) _Pragma("unroll") for (int k = 0; k < 2; ++k) \
        acc[ai][bj][m][n] = __builtin_amdgcn_mfma_f32_16x16x32_bf16(Bt[n][k], At[m][k], acc[ai][bj][m][n], 0, 0, 0); __builtin_amdgcn_s_setprio(0); } while (0)
#define PG8_WAIT_V(n) asm volatile("s_waitcnt vmcnt(" #n ")" ::: "memory")
#define PG8_WAIT_L(n) asm volatile("s_waitcnt lgkmcnt(" #n ")" ::: "memory")
#define PG8_BAR __builtin_amdgcn_s_barrier()
#define PG8_SCHED __builtin_amdgcn_sched_barrier(0)
    Unit cur, nxt; int ui = 0;
    if (!S.next(0, cur)) return;
    f32x4 acc[2][2][4][2];
#pragma unroll
    for (int a = 0; a < 2; ++a)
#pragma unroll
        for (int b = 0; b < 2; ++b)
#pragma unroll
            for (int m = 0; m < 4; ++m)
#pragma unroll
                for (int n = 0; n < 2; ++n) acc[a][b][m][n] = (f32x4){0.f, 0.f, 0.f, 0.f};
    bf16x8 At[4][2], B0[2][2], B1[2][2];
    unsigned va[2][2];
    PG8_LAS u32x4* vslot = (PG8_LAS u32x4*)(lds + VN_SLOT_OFF) + tid;
    S.aoff(cur, Rp, Cp, va);
    const char* cA = cur.abase; const char* cB0 = cur.b0; const char* cB1 = cur.b1;
    PG8_STAGE(PG8_SB(0, 0), cB0, voffB); PG8_STAGE(PG8_SB(0, 1), cB1, voffB); PG8_STAGE(PG8_SA(0, 0), cA, va[0]); PG8_STAGE(PG8_SA(0, 1), cA, va[1]);
    if (wr == 1) PG8_BAR;
    PG8_WAIT_V(2); PG8_BAR;
    PG8_STAGE(PG8_SB(1, 0), cB0 + kstep, voffB); PG8_STAGE(PG8_SA(1, 0), cA + kstep, va[0]); PG8_STAGE(PG8_SB(1, 1), cB1 + kstep, voffB);
    PG8_WAIT_V(6); PG8_BAR;
    for (;;) {
        const bool has_next = S.next(ui + 1, nxt);
        if constexpr (Sched::GATHER) { unsigned vn[2][2]; if (has_next) S.aoff(nxt, Rp, Cp, vn); else { vn[0][0] = va[0][0]; vn[0][1] = va[0][1]; vn[1][0] = va[1][0]; vn[1][1] = va[1][1]; }
            *vslot = (u32x4){vn[0][0], vn[0][1], vn[1][0], vn[1][1]}; }
        const char* nA = has_next ? nxt.abase : cA; const char* nB0 = has_next ? nxt.b0 : cB0; const char* nB1 = has_next ? nxt.b1 : cB1;
        for (int t = 0; t < nt; t += 2) {
            const bool last = (t == nt - 2);
            const char* a1 = cA + (size_t)(t + 1) * kstep;
            const char* a2 = last ? nA : cA + (size_t)(t + 2) * kstep;
            const char* b20 = last ? nB0 : cB0 + (size_t)(t + 2) * kstep; const char* b21 = last ? nB1 : cB1 + (size_t)(t + 2) * kstep;
            const char* a3 = a2 + kstep; const char* b30 = b20 + kstep; const char* b31 = b21 + kstep;
            PG8_LDB(B0, 0, 0); PG8_LDB(B1, 0, 1); PG8_SCHED; PG8_LDA(At, 0, 0); PG8_STAGE(PG8_SA(1, 1), a1, va[1]);
            PG8_WAIT_V(8); PG8_WAIT_L(0); PG8_BAR; PG8_MMA(0, 0, At, B0); PG8_MMA(0, 1, At, B1); PG8_BAR; PG8_SCHED;
            if constexpr (Sched::GATHER) { if (last) { const u32x4 q = *vslot; va[0][0] = q[0]; va[0][1] = q[1]; va[1][0] = q[2]; va[1][1] = q[3]; } }
            PG8_LDA(At, 0, 1); PG8_STAGE(PG8_SB(0, 0), b20, voffB); PG8_STAGE(PG8_SB(0, 1), b21, voffB); PG8_STAGE(PG8_SA(0, 0), a2, va[0]);
            PG8_WAIT_V(8); PG8_WAIT_L(0); PG8_BAR; PG8_MMA(1, 0, At, B0); PG8_MMA(1, 1, At, B1); PG8_BAR; PG8_SCHED;
            PG8_LDB(B0, 1, 0); PG8_LDB(B1, 1, 1); PG8_SCHED; PG8_LDA(At, 1, 0); PG8_STAGE(PG8_SA(0, 1), a2, va[1]);
            PG8_WAIT_V(8); PG8_WAIT_L(0); PG8_BAR; PG8_MMA(0, 0, At, B0); PG8_MMA(0, 1, At, B1); PG8_BAR; PG8_SCHED;
            PG8_LDA(At, 1, 1); PG8_STAGE(PG8_SB(1, 0), b30, voffB); PG8_STAGE(PG8_SB(1, 1), b31, voffB); PG8_STAGE(PG8_SA(1, 0), a3, va[0]);
            PG8_WAIT_V(8); PG8_WAIT_L(0); PG8_BAR; PG8_MMA(1, 0, At, B0); PG8_MMA(1, 1, At, B1); PG8_BAR; PG8_SCHED;
        }
        if (wr == 0) PG8_BAR;
        E(acc, cur, wr, wc, fr, fq);
        if (!has_next) break;
#pragma unroll
        for (int a = 0; a < 2; ++a)
#pragma unroll
            for (int b = 0; b < 2; ++b)
#pragma unroll
                for (int m = 0; m < 4; ++m)
#pragma unroll
                    for (int n = 0; n < 2; ++n) acc[a][b][m][n] = (f32x4){0.f, 0.f, 0.f, 0.f};
        cur = nxt; cA = nA; cB0 = nB0; cB1 = nB1; ++ui;
        if (wr == 1) PG8_BAR;
    }
    PG8_WAIT_V(0);
    PG8_BAR;
#undef PG8_SA
#undef PG8_SB
#undef PG8_STAGE
#undef PG8_LDA
#undef PG8_LDB
#undef PG8_MMA
#undef PG8_WAIT_V
#undef PG8_WAIT_L
#undef PG8_BAR
#undef PG8_SCHED
}
}
namespace {
constexpr int D = 1024, NB = 8, SEQ = 2048, T = NB * SEQ, PW = 3584, SW = 512, NG = 32, NP = 64, NHC = 16;
constexpr int GW = 512, NHEAD = 8, HD = 64, CHUNK = 128, NCH = SEQ / CHUNK, NE = 32, TOPK = 4, DE = 1024, NMOD = 6;
constexpr int PADROWS = T * TOPK + NE * 256;
constexpr float EPS = 1e-6f;
constexpr int NWAVES = 8, NTHREADS = NWAVES * 64;
constexpr int MODK = 8;

#define GAS __attribute__((address_space(1)))
#define LAS __attribute__((address_space(3)))
typedef unsigned short bf16;
typedef unsigned v4u __attribute__((ext_vector_type(4)));
typedef unsigned v2u __attribute__((ext_vector_type(2)));
typedef int v4i __attribute__((ext_vector_type(4)));
typedef float f32x4 __attribute__((ext_vector_type(4)));
typedef float f32x2 __attribute__((ext_vector_type(2)));
typedef short bf16x8 __attribute__((ext_vector_type(8)));
typedef GAS unsigned gu32;
#define RLX_AGENT __ATOMIC_RELAXED, __HIP_MEMORY_SCOPE_AGENT
#define LDS_WAIT() asm volatile("s_waitcnt lgkmcnt(0)" ::: "memory")
#define VM_WAIT() asm volatile("s_waitcnt vmcnt(0)" ::: "memory")
__device__ __forceinline__ unsigned f2bf(float f) { unsigned u = __builtin_bit_cast(unsigned, f); return (u + 0x7fffu + ((u >> 16) & 1u)) >> 16; }
__device__ __forceinline__ unsigned pk2(float lo, float hi) { return f2bf(lo) | (f2bf(hi) << 16); }
__device__ __forceinline__ float bf2f(unsigned short b) { return __builtin_bit_cast(float, (unsigned)b << 16); }
__device__ __forceinline__ float bflo(unsigned w) { return __builtin_bit_cast(float, w << 16); }
__device__ __forceinline__ float bfhi(unsigned w) { return __builtin_bit_cast(float, w & 0xffff0000u); }
__device__ __forceinline__ float sigm(float x) { return __builtin_amdgcn_rcpf(1.f + __expf(-x)); }
__device__ __forceinline__ float gelu_t(float x) { const float u = 1.5957691216057308f * (x + 0.044715f * x * x * x); return x * sigm(u); }
__device__ __forceinline__ float wave_sum(float v) {
#pragma unroll
    for (int o = 1; o < 64; o <<= 1) v += __shfl_xor(v, o);
    return v;
}

constexpr size_t MiB = 1u << 20;
constexpr size_t WS_CTL = 0, CTL_ZERO_BYTES = 64 * 1024;
constexpr int CW_BAR = 1024;
constexpr size_t WS_MODP = 1 * MiB;
constexpr size_t WS_MOD = 3 * MiB;
constexpr size_t WS_WSM = 4 * MiB;
constexpr size_t WS_CMT = WS_WSM + 512 * 1024;
constexpr size_t WS_RWT = 5 * MiB;
constexpr size_t WS_ROUTE = 6 * MiB;
constexpr size_t WS_SEG = WS_ROUTE + 192 * 1024, WS_SROW = WS_ROUTE + 256 * 1024;
constexpr size_t WS_TOPI = 7 * MiB, WS_TOPW = WS_TOPI + 256 * 1024, WS_POS = WS_TOPW + 256 * 1024;
constexpr size_t WS_KERN = 8 * MiB;
constexpr size_t WS_LAMT = 10 * MiB;
constexpr size_t WS_E = 13 * MiB;
constexpr size_t WS_ME = 16 * MiB;
constexpr size_t WS_WINT = 32 * MiB;
constexpr size_t WS_GLUT = 40 * MiB;
constexpr size_t WS_WAT = 41 * MiB, WS_WBT = 42 * MiB;
constexpr size_t WS_WOT = 43 * MiB;
constexpr size_t WS_W1T = 48 * MiB;
constexpr size_t WS_W2T = 176 * MiB;
constexpr size_t WS_X1 = 240 * MiB;
constexpr size_t WS_H2 = 304 * MiB;
constexpr size_t WS_RX = 336 * MiB;
constexpr size_t WS_RY = 480 * MiB;
constexpr size_t WS_H1 = WS_RY, WS_Z = WS_RY + 32 * MiB, WS_GM = WS_RY + 48 * MiB, WS_OA = WS_RY + 64 * MiB, WS_MB = WS_RY + 80 * MiB, WS_MRG = WS_RY + 112 * MiB;
constexpr size_t WS_END = 624 * MiB;
static_assert((size_t)PADROWS * 1024 * 2 <= 144 * MiB, "act / ys fit their regions");

constexpr int RING_BYTES = 131072;
constexpr int LDSCTL_OFF = RING_BYTES, MISC_OFF = LDSCTL_OFF + 320;
constexpr int LDS_BYTES = 147456;

#define XB_TMO      128
#define XB_XCNT(j)  (256  + 64 * (j))
#define XB_XSUB(j)  (1280 + 64 * (j))
#define XB_XGEN(j)  (2304 + 64 * (j))
#define XB_TOP      3328
#define XB_TOPGEN   3392
#define XCD_BAR_WORDS 3456
#define XB_SPIN_CAP (1u << 18)
__device__ __forceinline__ unsigned xb_ld(unsigned* p)              { return __hip_atomic_load(p, __ATOMIC_RELAXED, __HIP_MEMORY_SCOPE_AGENT); }
__device__ __forceinline__ unsigned xb_add(unsigned* p, unsigned v) { return __hip_atomic_fetch_add(p, v, __ATOMIC_RELAXED, __HIP_MEMORY_SCOPE_AGENT); }
__device__ __forceinline__ unsigned xb_xcc_id() { return (unsigned)__builtin_amdgcn_s_getreg((3 << 11) | 20) & 0xFu; }
#define XB_SPIN(cond, bar) do { unsigned _sp = 0; while (cond) { __builtin_amdgcn_s_sleep(1); \
    if ((++_sp & 255u) == 0u) { if (xb_ld(&(bar)[XB_TMO])) break; if (_sp > XB_SPIN_CAP) { atomicAdd(&(bar)[XB_TMO], 1u); break; } } } } while (0)
struct XcdBarrier { unsigned* bar; unsigned x; volatile LAS unsigned* st; };
__device__ __forceinline__ XcdBarrier xcd_barrier_post(unsigned* bar, volatile LAS unsigned* st) {
    XcdBarrier b; b.bar = bar; b.x = xb_xcc_id(); b.st = st;
    if (threadIdx.x == 0) (void)xb_add(&bar[XB_XCNT(b.x)], 1u);
    return b;
}
__device__ __forceinline__ void xcd_barrier_complete(unsigned* bar, unsigned x, unsigned& nloc, unsigned& nx) {
    const unsigned G = gridDim.x * gridDim.y * gridDim.z;
    unsigned sum, cnt, mine, sp = 0u;
    for (;;) {
        sum = 0u; cnt = 0u; mine = 0u;
#pragma unroll
        for (unsigned j = 0; j < 16; ++j) { const unsigned c = xb_ld(&bar[XB_XCNT(j)]); sum += c; cnt += (c > 0u) ? 1u : 0u; mine = (j == x) ? c : mine; }
        if (sum == G) break;
        __builtin_amdgcn_s_sleep(1);
        if ((++sp & 255u) == 0u) { if (xb_ld(&bar[XB_TMO])) break; if (sp > XB_SPIN_CAP) { atomicAdd(&bar[XB_TMO], 1u); break; } }
    }
    nloc = mine > 0u ? mine : 1u; nx = cnt > 0u ? cnt : 1u;
}
__device__ __forceinline__ void xcd_barrier(const XcdBarrier& b) {
    asm volatile("s_waitcnt vmcnt(0)" ::: "memory");
    __syncthreads();
    if (threadIdx.x == 0) {
        unsigned* bar = b.bar;
        __builtin_amdgcn_s_waitcnt(0);
        unsigned nloc = b.st[0], nx = b.st[1];
        if (nloc == 0u) { xcd_barrier_complete(bar, b.x, nloc, nx); b.st[0] = nloc; b.st[1] = nx; }
        const unsigned old = xb_add(&bar[XB_XSUB(b.x)], 1u);
        const unsigned gen = old / nloc;
        if (old + 1u == (gen + 1u) * nloc) {
            __builtin_amdgcn_fence(__ATOMIC_RELEASE, "agent");
            asm volatile("s_waitcnt vmcnt(0)" ::: "memory");
            const unsigned og = xb_add(&bar[XB_TOP], 1u);
            const unsigned tg = og / nx;
            if (og + 1u == (tg + 1u) * nx) xb_add(&bar[XB_TOPGEN], 1u);
            else XB_SPIN(xb_ld(&bar[XB_TOPGEN]) == tg, bar);
            __builtin_amdgcn_fence(__ATOMIC_ACQUIRE, "agent");
            xb_add(&bar[XB_XGEN(b.x)], 1u);
            asm volatile("s_waitcnt vmcnt(0)" ::: "memory");
        } else {
            XB_SPIN(xb_ld(&bar[XB_XGEN(b.x)]) == gen, bar);
            __builtin_amdgcn_fence(__ATOMIC_ACQUIRE, "agent");
            asm volatile("s_waitcnt vmcnt(0)" ::: "memory");
        }
    }
    __syncthreads();
}

struct Args { const float* in[31]; float* out; unsigned char* ws; int ph_lo, ph_hi; };
struct Frame {
    LAS unsigned char* lds;
    int wave, vcu, G;
};
struct DenseOrder {
    const char* A; const char* Bt; int K, nM, nN, nwg, G, c;
    __device__ __forceinline__ void init(const void* A_, const void* Bt_, int M, int N, int K_, int G_, int c_) { A = (const char*)A_; Bt = (const char*)Bt_; K = K_; nM = M / 256; nN = N / 256; nwg = nM * nN; G = G_; c = c_; }
    __device__ __forceinline__ bool next(int i, pg8::Unit& u) const {
        const long L = (long)i * G + c; if (L >= nwg) return false;
        int wgid = (int)L; { const int q = nwg / 8, r = nwg % 8, xcd = wgid % 8, off = wgid / 8; wgid = (xcd < r ? xcd * (q + 1) : r * (q + 1) + (xcd - r) * q) + off; }
        const int nig = 8 * nN, gid = wgid / nig, fm = gid * 8, gsz = (nM - fm) < 8 ? (nM - fm) : 8;
        u.pm = fm + ((wgid % nig) % gsz); u.pn = (wgid % nig) / gsz; u.aux = 0;
        u.abase = A + (size_t)u.pm * 256 * K * 2; u.b0 = Bt + (size_t)u.pn * 256 * K * 2; u.b1 = u.b0 + (size_t)128 * K * 2; return true;
    }
    static constexpr bool GATHER = false;
    __device__ __forceinline__ void aoff(const pg8::Unit&, const int (&R)[2], const int (&C)[2], unsigned (&va)[2][2]) const {
#pragma unroll
        for (int h = 0; h < 2; ++h)
#pragma unroll
            for (int i = 0; i < 2; ++i) va[h][i] = (unsigned)((h * 128 + R[i]) * K + C[i]) * 2u;
    }
};

__device__ __forceinline__ void p0_transpose_item(const float* W, int K, int N, bf16* WT, LAS float* scr, int item, int lane) {
    const int nblk = N / 32, kb = item / nblk, nb = item % nblk, k0 = 64 * kb, n0 = 32 * nb;
#pragma unroll 8
    for (int i = 0; i < 32; ++i) { const int kk = 2 * i + (lane >> 5); scr[kk * 33 + (lane & 31)] = W[(size_t)(k0 + kk) * N + n0 + (lane & 31)]; }
    LDS_WAIT(); asm volatile("" ::: "memory");
    const int c = lane & 7;
#pragma unroll
    for (int j = 0; j < 4; ++j) { const int n = (lane >> 3) + 8 * j; const LAS float* s = scr + (8 * c) * 33 + n;
        v4u o; o.x = pk2(s[0 * 33], s[1 * 33]); o.y = pk2(s[2 * 33], s[3 * 33]); o.z = pk2(s[4 * 33], s[5 * 33]); o.w = pk2(s[6 * 33], s[7 * 33]);
        *(GAS v4u*)(WT + (size_t)(n0 + n) * K + k0 + 8 * c) = o; }
    LDS_WAIT(); asm volatile("" ::: "memory");
}
__device__ __forceinline__ void p0_s5_item(const Args& A, unsigned char* ws, LAS float* scr, int item, int lane) {
    const int g = item / 129, tau = item % 129, p = lane;
    const float* a_re = A.in[6]; const float* a_im = A.in[7]; const float* log_dt = A.in[8]; const float* b_re = A.in[9]; const float* b_im = A.in[10]; const float* c_re = A.in[11]; const float* c_im = A.in[12];
    const double dt = exp((double)log_dt[g]);
    const double lr = a_re[g * NP + p], li = a_im[g * NP + p];
    const double mg = exp(lr * dt * (double)tau), an = li * dt * (double)tau;
    const float ltr = (float)(mg * cos(an)), lti = (float)(mg * sin(an));
    ((GAS f32x2*)(ws + WS_LAMT))[(size_t)(g * 129 + tau) * NP + p] = (f32x2){ltr, lti};
    if (tau == 128) return;
    const double m1 = exp(lr * dt), lbr = m1 * cos(li * dt), lbi = m1 * sin(li * dt);
    const double nr = lbr - 1.0, ni = lbi, den = lr * lr + li * li;
    const float cfr = (float)((nr * lr + ni * li) / den), cfi = (float)((ni * lr - nr * li) / den);
    const float wr_ = ltr * cfr - lti * cfi, wi_ = ltr * cfi + lti * cfr;
    const f32x4* brp = (const f32x4*)(b_re + (size_t)(g * NP + p) * NHC); const f32x4* bip = (const f32x4*)(b_im + (size_t)(g * NP + p) * NHC);
    unsigned mre[8], mim[8];
#pragma unroll
    for (int q = 0; q < 4; ++q) { const f32x4 br = brp[q], bi = bip[q]; float vr[4], vi[4];
#pragma unroll
        for (int j = 0; j < 4; ++j) { vr[j] = wr_ * br[j] - wi_ * bi[j]; vi[j] = wr_ * bi[j] + wi_ * br[j]; scr[(p * 16 + q * 4 + j) * 2] = vr[j]; scr[(p * 16 + q * 4 + j) * 2 + 1] = vi[j]; }
        mre[2 * q] = pk2(vr[0], vr[1]); mre[2 * q + 1] = pk2(vr[2], vr[3]); mim[2 * q] = pk2(vi[0], vi[1]); mim[2 * q + 1] = pk2(vi[2], vi[3]); }
    { GAS v4u* o = (GAS v4u*)((bf16*)(ws + WS_ME) + ((size_t)(g * 128 + 2 * p) * 2048 + (127 - tau) * 16));
      o[0] = (v4u){mre[0], mre[1], mre[2], mre[3]}; o[1] = (v4u){mre[4], mre[5], mre[6], mre[7]};
      GAS v4u* o2 = (GAS v4u*)((bf16*)(ws + WS_ME) + ((size_t)(g * 128 + 2 * p + 1) * 2048 + (127 - tau) * 16));
      o2[0] = (v4u){mim[0], mim[1], mim[2], mim[3]}; o2[1] = (v4u){mim[4], mim[5], mim[6], mim[7]}; }
    LDS_WAIT(); asm volatile("" ::: "memory");
    const int ho = lane >> 2, hi0 = 4 * (lane & 3);
    const float* crp = c_re + (size_t)(g * NHC + ho) * NP; const float* cip = c_im + (size_t)(g * NHC + ho) * NP;
    float kk[4] = {0.f, 0.f, 0.f, 0.f};
    for (int pp = 0; pp < NP; ++pp) { const float cr = crp[pp], ci = cip[pp];
#pragma unroll
        for (int j = 0; j < 4; ++j) { const f32x2 w = *(const LAS f32x2*)(scr + (pp * 16 + hi0 + j) * 2); kk[j] += cr * w.x - ci * w.y; } }
    *(GAS v2u*)((bf16*)(ws + WS_KERN) + ((size_t)(g * 128 + tau) * 256 + ho * 16 + hi0)) = (v2u){pk2(kk[0], kk[1]), pk2(kk[2], kk[3])};
    LDS_WAIT(); asm volatile("" ::: "memory");
}
__device__ __forceinline__ void p0_mod_item(const Args& A, unsigned char* ws, LAS float* scr, int item, int lane) {
    const float* c = A.in[1]; const float* ada_w = A.in[2]; const float* ada_b = A.in[3];
    const int j = item * 64 + lane;
    float acc[8];
#pragma unroll
    for (int b = 0; b < 8; ++b) acc[b] = ada_b[j];
    for (int half = 0; half < 2; ++half) {
        for (int i = lane; i < 8 * 512; i += 64) { const int b = i >> 9, k = i & 511; const float cv = c[b * D + half * 512 + k]; scr[k * 8 + b] = cv / (1.f + __expf(-cv)); }
        LDS_WAIT(); asm volatile("" ::: "memory");
#pragma unroll 4
        for (int k = 0; k < 512; ++k) { const float w = ada_w[(size_t)(half * 512 + k) * (NMOD * D) + j];
            const f32x4 s0 = *(const LAS f32x4*)(scr + k * 8), s1 = *(const LAS f32x4*)(scr + k * 8 + 4);
            acc[0] += s0[0] * w; acc[1] += s0[1] * w; acc[2] += s0[2] * w; acc[3] += s0[3] * w; acc[4] += s1[0] * w; acc[5] += s1[1] * w; acc[6] += s1[2] * w; acc[7] += s1[3] * w; }
        LDS_WAIT(); asm volatile("" ::: "memory");
    }
#pragma unroll
    for (int b = 0; b < 8; ++b) ((float*)(ws + WS_MOD))[b * (NMOD * D) + j] = acc[b];
}
__device__ __forceinline__ void p0_prologue(const Args& A, const Frame& F) {
    unsigned char* ws = A.ws;
    LAS float* scr = (LAS float*)(F.lds + F.wave * 16384);
    const int gw = F.vcu * NWAVES + F.wave, NGW = F.G * NWAVES;
    constexpr int I_S5 = NG * 129, I_MOD = NMOD * D / 64;
    constexpr int I_WIN = (D / 64) * (PW / 32), I_GLU = (SW / 64) * (SW / 32), I_BR = (SW / 64) * (D / 32), I_WO = (D / 64) * (D / 32), I_M1 = (D / 64) * (2 * DE / 32), I_M2 = (DE / 64) * (D / 32);
    constexpr int NITEMS = I_S5 + I_MOD + I_WIN + I_GLU + 2 * I_BR + I_WO + NE * I_M1 + NE * I_M2;
    for (int it = gw; it < NITEMS; it += NGW) {
        int r = it;
        if (r < I_S5) { p0_s5_item(A, ws, scr, r, ((int)threadIdx.x & 63)); continue; } r -= I_S5;
        if (r < I_MOD) { p0_mod_item(A, ws, scr, r, ((int)threadIdx.x & 63)); continue; } r -= I_MOD;
        if (r < I_WIN) { p0_transpose_item(A.in[5], D, PW, (bf16*)(ws + WS_WINT), scr, r, ((int)threadIdx.x & 63)); continue; } r -= I_WIN;
        if (r < I_GLU) { p0_transpose_item(A.in[14], SW, SW, (bf16*)(ws + WS_GLUT), scr, r, ((int)threadIdx.x & 63)); continue; } r -= I_GLU;
        if (r < I_BR) { p0_transpose_item(A.in[16], SW, D, (bf16*)(ws + WS_WAT), scr, r, ((int)threadIdx.x & 63)); continue; } r -= I_BR;
        if (r < I_BR) { p0_transpose_item(A.in[21], SW, D, (bf16*)(ws + WS_WBT), scr, r, ((int)threadIdx.x & 63)); continue; } r -= I_BR;
        if (r < I_WO) { p0_transpose_item(A.in[22], D, D, (bf16*)(ws + WS_WOT), scr, r, ((int)threadIdx.x & 63)); continue; } r -= I_WO;
        if (r < NE * I_M1) { const int e = r / I_M1; p0_transpose_item(A.in[26] + (size_t)e * D * 2 * DE, D, 2 * DE, (bf16*)(ws + WS_W1T) + (size_t)e * 2 * DE * D, scr, r % I_M1, ((int)threadIdx.x & 63)); continue; } r -= NE * I_M1;
        { const int e = r / I_M2; p0_transpose_item(A.in[28] + (size_t)e * DE * D, DE, D, (bf16*)(ws + WS_W2T) + (size_t)e * D * DE, scr, r % I_M2, ((int)threadIdx.x & 63)); }
    }
    const int gt = F.vcu * NTHREADS + ((int)threadIdx.x), NGT = F.G * NTHREADS;
    for (int i = gt; i < NG * NHC * 128; i += NGT) { const int k = i & 127, ho = (i >> 7) & 15, g = i >> 11, p = k >> 1;
        const float v = (k & 1) ? -A.in[12][(size_t)(g * NHC + ho) * NP + p] : A.in[11][(size_t)(g * NHC + ho) * NP + p]; ((bf16*)(ws + WS_CMT))[i] = (bf16)f2bf(v); }
    for (int i = gt; i < NHEAD * CHUNK * CHUNK; i += NGT) { const int s = i & 127, t = (i >> 7) & 127; ((bf16*)(ws + WS_WSM))[i] = (s <= t) ? (bf16)f2bf(A.in[19][i]) : (bf16)0; }
    for (int i = gt; i < D * NE; i += NGT) { const int e = i & 31, k = i >> 5; const float v = A.in[24][i]; const unsigned hi = f2bf(v); const float lo = v - bf2f((unsigned short)hi);
        ((bf16*)(ws + WS_RWT))[e * D + k] = (bf16)hi; ((bf16*)(ws + WS_RWT))[NE * D + e * D + k] = (bf16)f2bf(lo); }
}

__device__ __forceinline__ void norm_mod_row_bf16(const float* xrow, const float* g, const float* shift, const float* scale, bf16* orow, int lane) {
    const GAS f32x4* xr = (const GAS f32x4*)xrow + lane;
    f32x4 v[4]; float s = 0.f;
#pragma unroll
    for (int j = 0; j < 4; ++j) { v[j] = xr[64 * j]; s += (v[j].x * v[j].x + v[j].y * v[j].y) + (v[j].z * v[j].z + v[j].w * v[j].w); }
    const float r = rsqrtf(wave_sum(s) * (1.f / D) + EPS);
    GAS v2u* o8 = (GAS v2u*)orow + lane;
#pragma unroll
    for (int j = 0; j < 4; ++j) { const f32x4 gg = ((const GAS f32x4*)g)[lane + 64 * j], sh = ((const GAS f32x4*)shift)[lane + 64 * j], sc = ((const GAS f32x4*)scale)[lane + 64 * j];
        const f32x4 o = v[j] * r * gg * (sc + 1.f) + sh; o8[64 * j] = (v2u){pk2(o.x, o.y), pk2(o.z, o.w)}; }
}
__device__ __forceinline__ void p1_h1(const Args& A, const Frame& F) {
    const int gw = F.vcu * NWAVES + F.wave, NGW = F.G * NWAVES;
    const float* mod = (const float*)(A.ws + WS_MOD);
    for (int m = gw; m < T; m += NGW) { const int b = m / SEQ;
        norm_mod_row_bf16(A.in[0] + (size_t)m * D, A.in[4], mod + b * (NMOD * D), mod + b * (NMOD * D) + D, (bf16*)(A.ws + WS_H1) + (size_t)m * D, ((int)threadIdx.x & 63)); }
}

struct EpiProj {
    static constexpr bool PERM = true;
    bf16* O;
    __device__ __forceinline__ void operator()(const pg8::f32x4 (&acc)[2][2][4][2], const pg8::Unit& u, int wr, int wc, int fr, int fq) const {
        const int row0 = u.pm * 256 + wr * 64 + fr, col0 = u.pn * 256 + wc * 32 + 8 * fq;
        const int mode = u.pn < 2 ? 0 : (u.pn < 6 ? 1 : 2);
#pragma unroll
        for (int ai = 0; ai < 2; ++ai)
#pragma unroll
            for (int m = 0; m < 4; ++m) { bf16* rowp = O + (size_t)(row0 + ai * 128 + m * 16) * PW + col0;
#pragma unroll
                for (int bj = 0; bj < 2; ++bj) { float v[8];
#pragma unroll
                    for (int j = 0; j < 4; ++j) { v[j] = acc[ai][bj][m][0][j]; v[4 + j] = acc[ai][bj][m][1][j]; }
                    if (mode == 1) {
#pragma unroll
                        for (int j = 0; j < 8; ++j) v[j] = gelu_t(v[j]); }
                    else if (mode == 2) {
#pragma unroll
                        for (int j = 0; j < 8; ++j) v[j] = sigm(v[j]); }
                    *(v4u*)(rowp + bj * 128) = (v4u){pk2(v[0], v[1]), pk2(v[2], v[3]), pk2(v[4], v[5]), pk2(v[6], v[7])}; } }
    }
};
__device__ __forceinline__ void p2_proj(const Args& A, const Frame& F) {
    DenseOrder S; S.init(A.ws + WS_H1, A.ws + WS_WINT, T, PW, D, F.G, (int)blockIdx.x);
    EpiProj E{(bf16*)(A.ws + WS_RX)};
    pg8::gemm_phase<EpiProj, DenseOrder>(F.lds, D, S, E);
}
__device__ __forceinline__ void p3_epass_unit(const Args& A, const Frame& F, int unit) {
    const int b = unit >> 5, g = unit & 31, lane = ((int)threadIdx.x & 63), m = lane & 15, kq = lane >> 4;
    const bf16* PA = (const bf16*)(A.ws + WS_RX);
    const bf16* ua = PA + ((size_t)(b * SEQ + m * CHUNK) * PW + g * NHC + 8 * (kq & 1));
    const bf16* mb = (const bf16*)(A.ws + WS_ME) + ((size_t)(g * 128 + F.wave * 16 + m) * 2048 + 8 * kq);
    f32x4 acc = {0.f, 0.f, 0.f, 0.f};
#pragma unroll 1
    for (int k0 = 0; k0 < 64; k0 += 8) {
        bf16x8 af[8], bfr[8];
#pragma unroll
        for (int j = 0; j < 8; ++j) { const int kk = k0 + j; af[j] = *(const GAS bf16x8*)(ua + (size_t)(2 * kk + (kq >> 1)) * PW); bfr[j] = *(const GAS bf16x8*)(mb + 32 * kk); }
#pragma unroll
        for (int j = 0; j < 8; ++j) acc = __builtin_amdgcn_mfma_f32_16x16x32_bf16(bfr[j], af[j], acc, 0, 0, 0);
    }
    *(GAS f32x4*)((float*)(A.ws + WS_E) + ((size_t)((b * NCH + m) * NG + g) * 128 + F.wave * 16 + 4 * kq)) = acc;
}

constexpr int VNT_STRIDE = 272;
__device__ __forceinline__ void p3_gmlp_unit(const Args& A, const Frame& F, int unit) {
    const int chunk = unit >> 1, hh = unit & 1, lane = ((int)threadIdx.x & 63), w = F.wave;
    const bf16* PA = (const bf16*)(A.ws + WS_RX);
    const float* lng = A.in[17]; const float* lnb = A.in[18];
    const f32x4 g0 = *(const GAS f32x4*)(lng + 8 * lane), g1 = *(const GAS f32x4*)(lng + 8 * lane + 4), b0 = *(const GAS f32x4*)(lnb + 8 * lane), b1 = *(const GAS f32x4*)(lnb + 8 * lane + 4);
#pragma unroll 4
    for (int i = 0; i < 16; ++i) {
        const int s = 16 * w + i;
        const v4u raw = *(const GAS v4u*)(PA + (size_t)(chunk * CHUNK + s) * PW + 2 * GW + 8 * lane);
        float v[8] = {bflo(raw.x), bfhi(raw.x), bflo(raw.y), bfhi(raw.y), bflo(raw.z), bfhi(raw.z), bflo(raw.w), bfhi(raw.w)};
        float sm = 0.f;
#pragma unroll
        for (int j = 0; j < 8; ++j) sm += v[j];
        const float mu = wave_sum(sm) * (1.f / GW);
        float sq = 0.f;
#pragma unroll
        for (int j = 0; j < 8; ++j) { v[j] -= mu; sq += v[j] * v[j]; }
        const float r = rsqrtf(wave_sum(sq) * (1.f / GW) + EPS);
        if ((lane >> 5) == hh) {
            LAS unsigned char* dst = F.lds + (8 * (lane & 31)) * VNT_STRIDE + 2 * s;
#pragma unroll
            for (int j = 0; j < 8; ++j) { const float o = v[j] * r * (j < 4 ? g0[j & 3] : g1[j & 3]) + (j < 4 ? b0[j & 3] : b1[j & 3]); *(LAS unsigned short*)(dst + j * VNT_STRIDE) = (unsigned short)f2bf(o); }
        }
    }
    LDS_WAIT(); __syncthreads();
    const int hl = w >> 1, th = w & 1, h = 4 * hh + hl, fr = lane & 15, kq = lane >> 4;
    const bf16* wsm = (const bf16*)(A.ws + WS_WSM) + (size_t)h * CHUNK * CHUNK;
    f32x4 acc[4][4];
#pragma unroll
    for (int cb = 0; cb < 4; ++cb)
#pragma unroll
        for (int tb = 0; tb < 4; ++tb) acc[cb][tb] = (f32x4){0.f, 0.f, 0.f, 0.f};
    const int kmax = th ? 4 : 2;
    for (int kk = 0; kk < kmax; ++kk) {
        bf16x8 vf[4], wf[4];
#pragma unroll
        for (int cb = 0; cb < 4; ++cb) vf[cb] = *(const LAS bf16x8*)(F.lds + (64 * hl + 16 * cb + fr) * VNT_STRIDE + (32 * kk + 8 * kq) * 2);
#pragma unroll
        for (int tb = 0; tb < 4; ++tb) wf[tb] = *(const GAS bf16x8*)(wsm + (size_t)(64 * th + 16 * tb + fr) * CHUNK + 32 * kk + 8 * kq);
#pragma unroll
        for (int cb = 0; cb < 4; ++cb)
#pragma unroll
            for (int tb = 0; tb < 4; ++tb) acc[cb][tb] = __builtin_amdgcn_mfma_f32_16x16x32_bf16(vf[cb], wf[tb], acc[cb][tb], 0, 0, 0);
    }
    const float* bs = A.in[20] + h * CHUNK;
    bf16* GM = (bf16*)(A.ws + WS_GM);
#pragma unroll
    for (int tb = 0; tb < 4; ++tb) { const int t = 64 * th + 16 * tb + fr; const float bias = bs[t]; const size_t row = (size_t)(chunk * CHUNK + t);
#pragma unroll
        for (int cb = 0; cb < 4; ++cb) { const int cg = 256 * hh + 64 * hl + 16 * cb + 4 * kq;
            const v2u gu = *(const GAS v2u*)(PA + row * PW + GW + cg);
            const float o0 = bflo(gu.x) * (acc[cb][tb][0] + bias), o1 = bfhi(gu.x) * (acc[cb][tb][1] + bias), o2 = bflo(gu.y) * (acc[cb][tb][2] + bias), o3 = bfhi(gu.y) * (acc[cb][tb][3] + bias);
            *(GAS v2u*)(GM + row * GW + cg) = (v2u){pk2(o0, o1), pk2(o2, o3)}; } }
    __syncthreads();
}
__device__ __forceinline__ void p3_phase(const Args& A, const Frame& F) {
    for (int u = F.vcu; u < NB * NG + 2 * (T / CHUNK); u += F.G) { if (u < NB * NG) p3_epass_unit(A, F, u); else p3_gmlp_unit(A, F, u - NB * NG); }
}

constexpr int Y_KERN = 0, Y_UT = 65536, Y_UTW = 4608, Y_CMT = Y_UT + 8 * Y_UTW, Y_CMT_STRIDE = 272, Y_XS = Y_CMT + 16 * Y_CMT_STRIDE, Y_END = Y_XS + 8 * 512;
static_assert(Y_END <= RING_BYTES, "Y-pass LDS map");
__device__ __forceinline__ void p4_ypass_unit(const Args& A, const Frame& F, int unit) {
    int lane = ((int)threadIdx.x & 63), tid = ((int)threadIdx.x); asm volatile("" : "+v"(lane), "+v"(tid));
    const int g = unit >> 4, o = unit & 15, w = F.wave, gc = 8 * o + w, b = gc >> 4, c = gc & 15;
    int fr = lane & 15, kq = lane >> 4;
    const bf16* PA = (const bf16*)(A.ws + WS_RX);
    LAS unsigned char* lds = F.lds;
    { const GAS v4u* src = (const GAS v4u*)(A.ws + WS_KERN + (size_t)g * 65536);
#pragma unroll
      for (int i = 0; i < 8; ++i) *(LAS v4u*)(lds + Y_KERN + (tid + 512 * i) * 16) = src[tid + 512 * i]; }
    if (tid < 256) { const int ho = tid >> 4, ch = tid & 15; *(LAS v4u*)(lds + Y_CMT + ho * Y_CMT_STRIDE + ch * 16) = *(const GAS v4u*)(A.ws + WS_CMT + (size_t)(g * NHC + ho) * 256 + ch * 16); }
    LAS unsigned char* ut = lds + Y_UT + w * Y_UTW;
#pragma unroll
    for (int i = 0; i < 4; ++i) { const int id = lane + 64 * i, s = id >> 1, half = id & 1;
        *(LAS v4u*)(ut + half * 2304 + (16 + s) * 16) = *(const GAS v4u*)(PA + (size_t)(gc * CHUNK + s) * PW + g * NHC + 8 * half); }
    if (lane < 32) *(LAS v4u*)(ut + (lane >> 4) * 2304 + (lane & 15) * 16) = (v4u){0u, 0u, 0u, 0u};
    { const f32x2 l128 = ((const GAS f32x2*)(A.ws + WS_LAMT))[(size_t)(g * 129 + 128) * NP + lane];
      const GAS f32x2* ep = (const GAS f32x2*)((const float*)(A.ws + WS_E) + ((size_t)(b * NCH) * NG + g) * 128) + lane;
      float xr = 0.f, xi = 0.f;
      for (int cp = 0; cp < c; ++cp) { const f32x2 e = ep[(size_t)cp * NG * 64]; const float nr = l128.x * xr - l128.y * xi + e.x, ni = l128.x * xi + l128.y * xr + e.y; xr = nr; xi = ni; }
      *(LAS f32x2*)(lds + Y_XS + w * 512 + lane * 8) = (f32x2){xr, xi}; }
    LDS_WAIT(); __syncthreads();
    asm volatile("" : "+v"(lane)); fr = lane & 15; kq = lane >> 4;
    f32x4 acc[8];
#pragma unroll
    for (int i = 0; i < 8; ++i) acc[i] = (f32x4){0.f, 0.f, 0.f, 0.f};
    const LAS unsigned char* kbase = lds + Y_KERN + (kq >> 1) * 512 + fr * 32 + (kq & 1) * 16;
    const LAS unsigned char* ubase = ut + (kq & 1) * 2304 + (16 + fr - (kq >> 1)) * 16;
#pragma unroll 1
    for (int qb = 0; qb < 8; ++qb) {
#pragma unroll 1
        for (int ql = 0; ql < 8; ++ql) { const int q = 8 * qb + ql;
            const bf16x8 kf = *(const LAS bf16x8*)(kbase + q * 1024);
#pragma unroll
            for (int i = 0; i < 8; ++i) if (i >= qb) { const bf16x8 uf = *(const LAS bf16x8*)(ubase + (16 * i - 2 * q) * 16); acc[i] = __builtin_amdgcn_mfma_f32_16x16x32_bf16(kf, uf, acc[i], 0, 0, 0); }
        }
    }
    asm volatile("" : "+v"(lane)); fr = lane & 15; kq = lane >> 4;
    {
        bf16x8 cf[4]; float z[4][8], l16[4][8];
#pragma unroll
        for (int kk = 0; kk < 4; ++kk) {
            cf[kk] = *(const LAS bf16x8*)(lds + Y_CMT + fr * Y_CMT_STRIDE + (32 * kk + 8 * kq) * 2);
            const f32x4 x0 = *(const LAS f32x4*)(lds + Y_XS + w * 512 + (16 * kk + 4 * kq) * 8), x1 = *(const LAS f32x4*)(lds + Y_XS + w * 512 + (16 * kk + 4 * kq) * 8 + 16);
            const GAS f32x4* lp = (const GAS f32x4*)((const float*)(A.ws + WS_LAMT) + ((size_t)(g * 129 + fr + 1) * NP + 16 * kk + 4 * kq) * 2);
            const GAS f32x4* lq = (const GAS f32x4*)((const float*)(A.ws + WS_LAMT) + ((size_t)(g * 129 + 16) * NP + 16 * kk + 4 * kq) * 2);
            const f32x4 l0 = lp[0], l1 = lp[1], q0 = lq[0], q1 = lq[1];
            z[kk][0] = l0[0] * x0[0] - l0[1] * x0[1]; z[kk][1] = l0[0] * x0[1] + l0[1] * x0[0]; z[kk][2] = l0[2] * x0[2] - l0[3] * x0[3]; z[kk][3] = l0[2] * x0[3] + l0[3] * x0[2];
            z[kk][4] = l1[0] * x1[0] - l1[1] * x1[1]; z[kk][5] = l1[0] * x1[1] + l1[1] * x1[0]; z[kk][6] = l1[2] * x1[2] - l1[3] * x1[3]; z[kk][7] = l1[2] * x1[3] + l1[3] * x1[2];
#pragma unroll
            for (int j = 0; j < 4; ++j) { l16[kk][j] = q0[j]; l16[kk][4 + j] = q1[j]; }
        }
#pragma unroll
        for (int i = 0; i < 8; ++i) {
#pragma unroll
            for (int kk = 0; kk < 4; ++kk) {
                const v4u zp = (v4u){pk2(z[kk][0], z[kk][1]), pk2(z[kk][2], z[kk][3]), pk2(z[kk][4], z[kk][5]), pk2(z[kk][6], z[kk][7])};
                acc[i] = __builtin_amdgcn_mfma_f32_16x16x32_bf16(cf[kk], __builtin_bit_cast(bf16x8, zp), acc[i], 0, 0, 0);
                if (i < 7) {
#pragma unroll
                    for (int j = 0; j < 4; ++j) { const float zr = z[kk][2 * j], zi = z[kk][2 * j + 1], lr = l16[kk][2 * j], li = l16[kk][2 * j + 1]; z[kk][2 * j] = lr * zr - li * zi; z[kk][2 * j + 1] = lr * zi + li * zr; }
                }
            }
        }
    }
    asm volatile("" : "+v"(lane)); fr = lane & 15; kq = lane >> 4;
    const f32x4 dsk = *(const GAS f32x4*)(A.in[13] + g * NHC + 4 * kq);
    bf16* Z = (bf16*)(A.ws + WS_Z);
#pragma unroll
    for (int i = 0; i < 8; ++i) { const int t = 16 * i + fr;
        const v2u uu = *(const LAS v2u*)(ut + (kq >> 1) * 2304 + (16 + t) * 16 + (kq & 1) * 8);
        const float y0 = acc[i][0] + dsk[0] * bflo(uu.x), y1 = acc[i][1] + dsk[1] * bfhi(uu.x), y2 = acc[i][2] + dsk[2] * bflo(uu.y), y3 = acc[i][3] + dsk[3] * bfhi(uu.y);
        *(GAS v2u*)(Z + (size_t)(gc * CHUNK + t) * SW + g * NHC + 4 * kq) = (v2u){pk2(gelu_t(y0), gelu_t(y1)), pk2(gelu_t(y2), gelu_t(y3))}; }
    __syncthreads();
}
__device__ __forceinline__ void p4_phase(const Args& A, const Frame& F) {
    for (int u = F.vcu; u < NG * (T / CHUNK / 8); u += F.G) p4_ypass_unit(A, F, u);
}
struct P5Order {
    const char *GM, *WBT, *Z, *GLUT; int G, c;
    __device__ __forceinline__ bool next(int i, pg8::Unit& u) const {
        const long L = (long)i * G + c; if (L >= 384) return false;
        const bool glu = L >= 256; int wgid = glu ? (int)L - 256 : (int)L; const int nN = glu ? 2 : 4, nwg = 64 * nN;
        { const int q = nwg / 8, xcd = wgid % 8, off = wgid / 8; wgid = xcd * q + off; }
        const int nig = 8 * nN, gid = wgid / nig, fm = gid * 8;
        u.pm = fm + ((wgid % nig) % 8); u.pn = (wgid % nig) / 8; u.aux = glu ? 1 : 0;
        u.abase = (glu ? Z : GM) + (size_t)u.pm * 256 * SW * 2; u.b0 = (glu ? GLUT : WBT) + (size_t)u.pn * 256 * SW * 2; u.b1 = u.b0 + (size_t)128 * SW * 2; return true;
    }
    static constexpr bool GATHER = false;
    __device__ __forceinline__ void aoff(const pg8::Unit&, const int (&R)[2], const int (&C)[2], unsigned (&va)[2][2]) const {
#pragma unroll
        for (int h = 0; h < 2; ++h)
#pragma unroll
            for (int i = 0; i < 2; ++i) va[h][i] = (unsigned)((h * 128 + R[i]) * SW + C[i]) * 2u;
    }
};
struct EpiP5 {
    static constexpr bool PERM = true;
    const bf16* PA; const bf16* Z; const float* glu_b; bf16* MB; bf16* OA;
    __device__ __forceinline__ void operator()(const pg8::f32x4 (&acc)[2][2][4][2], const pg8::Unit& u, int wr, int wc, int fr, int fq) const {
        const int row0 = u.pm * 256 + wr * 64 + fr, col0 = u.pn * 256 + wc * 32 + 8 * fq;
        if (u.aux == 0) {
#pragma unroll
            for (int ai = 0; ai < 2; ++ai)
#pragma unroll
                for (int m = 0; m < 4; ++m) { const size_t row = (size_t)(row0 + ai * 128 + m * 16);
#pragma unroll
                    for (int bj = 0; bj < 2; ++bj) { const int col = col0 + bj * 128;
                        const v4u s = *(const GAS v4u*)(PA + row * PW + (SW + 2 * GW + D) + col);
                        const pg8::f32x4 a0 = acc[ai][bj][m][0], a1 = acc[ai][bj][m][1];
                        *(GAS v4u*)(MB + row * D + col) = (v4u){pk2(bflo(s.x) * a0[0], bfhi(s.x) * a0[1]), pk2(bflo(s.y) * a0[2], bfhi(s.y) * a0[3]), pk2(bflo(s.z) * a1[0], bfhi(s.z) * a1[1]), pk2(bflo(s.w) * a1[2], bfhi(s.w) * a1[3])}; } }
        } else {
#pragma unroll
            for (int bj = 0; bj < 2; ++bj) { const int col = col0 + bj * 128;
                const f32x4 b0 = *(const GAS f32x4*)(glu_b + col), b1 = *(const GAS f32x4*)(glu_b + col + 4);
#pragma unroll
                for (int ai = 0; ai < 2; ++ai)
#pragma unroll
                    for (int m = 0; m < 4; ++m) { const size_t row = (size_t)(row0 + ai * 128 + m * 16);
                        const v4u s = *(const GAS v4u*)(Z + row * SW + col);
                        const pg8::f32x4 a0 = acc[ai][bj][m][0], a1 = acc[ai][bj][m][1];
                        *(GAS v4u*)(OA + row * SW + col) = (v4u){pk2(bflo(s.x) * sigm(a0[0] + b0[0]), bfhi(s.x) * sigm(a0[1] + b0[1])), pk2(bflo(s.y) * sigm(a0[2] + b0[2]), bfhi(s.y) * sigm(a0[3] + b0[3])),
                                                                   pk2(bflo(s.z) * sigm(a1[0] + b1[0]), bfhi(s.z) * sigm(a1[1] + b1[1])), pk2(bflo(s.w) * sigm(a1[2] + b1[2]), bfhi(s.w) * sigm(a1[3] + b1[3]))}; } }
        }
    }
};
__device__ __forceinline__ void p5_phase(const Args& A, const Frame& F) {
    P5Order S{(const char*)(A.ws + WS_GM), (const char*)(A.ws + WS_WBT), (const char*)(A.ws + WS_Z), (const char*)(A.ws + WS_GLUT), F.G, (int)blockIdx.x};
    EpiP5 E{(const bf16*)(A.ws + WS_RX), (const bf16*)(A.ws + WS_Z), A.in[15], (bf16*)(A.ws + WS_MB), (bf16*)(A.ws + WS_OA)};
    pg8::gemm_phase<EpiP5, P5Order>(F.lds, SW, S, E);
}
struct EpiP6 {
    static constexpr bool PERM = true;
    const bf16* PA; const bf16* MB; bf16* MRG;
    __device__ __forceinline__ void operator()(const pg8::f32x4 (&acc)[2][2][4][2], const pg8::Unit& u, int wr, int wc, int fr, int fq) const {
        const int row0 = u.pm * 256 + wr * 64 + fr, col0 = u.pn * 256 + wc * 32 + 8 * fq;
#pragma unroll
        for (int ai = 0; ai < 2; ++ai)
#pragma unroll
            for (int m = 0; m < 4; ++m) { const size_t row = (size_t)(row0 + ai * 128 + m * 16);
#pragma unroll
                for (int bj = 0; bj < 2; ++bj) { const int col = col0 + bj * 128;
                    const v4u s = *(const GAS v4u*)(PA + row * PW + (SW + 2 * GW) + col); const v4u q = *(const GAS v4u*)(MB + row * D + col);
                    const pg8::f32x4 a0 = acc[ai][bj][m][0], a1 = acc[ai][bj][m][1];
                    *(GAS v4u*)(MRG + row * D + col) = (v4u){pk2(bflo(s.x) * a0[0] + bflo(q.x), bfhi(s.x) * a0[1] + bfhi(q.x)), pk2(bflo(s.y) * a0[2] + bflo(q.y), bfhi(s.y) * a0[3] + bfhi(q.y)),
                                                            pk2(bflo(s.z) * a1[0] + bflo(q.z), bfhi(s.z) * a1[1] + bfhi(q.z)), pk2(bflo(s.w) * a1[2] + bflo(q.w), bfhi(s.w) * a1[3] + bfhi(q.w))}; } }
    }
};
__device__ __forceinline__ void p6_phase(const Args& A, const Frame& F) {
    DenseOrder S; S.init(A.ws + WS_OA, A.ws + WS_WAT, T, D, SW, F.G, (int)blockIdx.x);
    EpiP6 E{(const bf16*)(A.ws + WS_RX), (const bf16*)(A.ws + WS_MB), (bf16*)(A.ws + WS_MRG)};
    pg8::gemm_phase<EpiP6, DenseOrder>(F.lds, SW, S, E);
}
struct EpiP7 {
    static constexpr bool PERM = false;
    const float* x; const float* mod; float* X1;
    __device__ __forceinline__ void operator()(const pg8::f32x4 (&acc)[2][2][4][2], const pg8::Unit& u, int wr, int wc, int fr, int fq) const {
        const int row0 = u.pm * 256 + wr * 64 + fr, col0 = u.pn * 256 + wc * 32 + 4 * fq;
        const float* g1 = mod + ((u.pm * 256) / SEQ) * (NMOD * D) + 2 * D;
        f32x4 gv[2][2];
#pragma unroll
        for (int bj = 0; bj < 2; ++bj)
#pragma unroll
            for (int n = 0; n < 2; ++n) gv[bj][n] = *(const GAS f32x4*)(g1 + col0 + bj * 128 + n * 16);
#pragma unroll
        for (int ai = 0; ai < 2; ++ai)
#pragma unroll
            for (int m = 0; m < 4; ++m) { const size_t off = (size_t)(row0 + ai * 128 + m * 16) * D + col0;
#pragma unroll
                for (int bj = 0; bj < 2; ++bj)
#pragma unroll
                    for (int n = 0; n < 2; ++n) { const f32x4 xv = *(const GAS f32x4*)(x + off + bj * 128 + n * 16); *(GAS f32x4*)(X1 + off + bj * 128 + n * 16) = xv + gv[bj][n] * acc[ai][bj][m][n]; } }
    }
};
__device__ __forceinline__ void p7_phase(const Args& A, const Frame& F) {
    DenseOrder S; S.init(A.ws + WS_MRG, A.ws + WS_WOT, T, D, D, F.G, (int)blockIdx.x);
    EpiP7 E{A.in[0], (const float*)(A.ws + WS_MOD), (float*)(A.ws + WS_X1)};
    pg8::gemm_phase<EpiP7, DenseOrder>(F.lds, D, S, E);
}
constexpr size_t WS_TE = WS_SEG + 1024;
constexpr int R_STRIDE = 2064, R_HI = 0, R_LO = 16 * R_STRIDE, R_PL = 2 * 16 * R_STRIDE, R_LG = R_PL + 8 * 2048, R_HIST = R_LG + 2048, R_END = R_HIST + 128;
static_assert(R_END <= RING_BYTES, "router LDS map");
__device__ __forceinline__ void p8_phase(const Args& A, const Frame& F) {
    LAS unsigned char* lds = F.lds;
    const int lane = ((int)threadIdx.x & 63), w = F.wave, tid = ((int)threadIdx.x), fr = lane & 15, kq = lane >> 4;
    const float* mod = (const float*)(A.ws + WS_MOD);
    const float* X1 = (const float*)(A.ws + WS_X1);
    bf16* H2 = (bf16*)(A.ws + WS_H2);
    const bf16* RW = (const bf16*)(A.ws + WS_RWT);
    if (tid < 32) *(LAS int*)(lds + R_HIST + tid * 4) = 0;
    for (int tile = blockIdx.x; tile < T / 16; tile += F.G) {
#pragma unroll
        for (int i = 0; i < 2; ++i) { const int tl = 2 * w + i, t = tile * 16 + tl, b = t / SEQ;
            const GAS f32x4* xr = (const GAS f32x4*)(X1 + (size_t)t * D) + lane;
            f32x4 v[4]; float s = 0.f;
#pragma unroll
            for (int j = 0; j < 4; ++j) { v[j] = xr[64 * j]; s += (v[j].x * v[j].x + v[j].y * v[j].y) + (v[j].z * v[j].z + v[j].w * v[j].w); }
            const float r = rsqrtf(wave_sum(s) * (1.f / D) + EPS);
            const float* mb = mod + b * (NMOD * D);
#pragma unroll
            for (int j = 0; j < 4; ++j) { const f32x4 gg = ((const GAS f32x4*)A.in[23])[lane + 64 * j], sh = ((const GAS f32x4*)(mb + 3 * D))[lane + 64 * j], sc = ((const GAS f32x4*)(mb + 4 * D))[lane + 64 * j];
                const f32x4 o = v[j] * r * gg * (sc + 1.f) + sh;
                const unsigned h0 = f2bf(o.x), h1 = f2bf(o.y), h2_ = f2bf(o.z), h3 = f2bf(o.w);
                const v2u hi = (v2u){h0 | (h1 << 16), h2_ | (h3 << 16)};
                const v2u lo = (v2u){pk2(o.x - bf2f((unsigned short)h0), o.y - bf2f((unsigned short)h1)), pk2(o.z - bf2f((unsigned short)h2_), o.w - bf2f((unsigned short)h3))};
                ((GAS v2u*)(H2 + (size_t)t * D))[lane + 64 * j] = hi;
                *(LAS v2u*)(lds + R_HI + tl * R_STRIDE + (lane + 64 * j) * 8) = hi; *(LAS v2u*)(lds + R_LO + tl * R_STRIDE + (lane + 64 * j) * 8) = lo; } }
        LDS_WAIT(); __syncthreads();
        { f32x4 acc[2] = {(f32x4){0.f, 0.f, 0.f, 0.f}, (f32x4){0.f, 0.f, 0.f, 0.f}};
#pragma unroll
          for (int kk = 0; kk < 4; ++kk) { const int k0 = 128 * w + 32 * kk + 8 * kq;
              const bf16x8 hh = *(const LAS bf16x8*)(lds + R_HI + fr * R_STRIDE + k0 * 2), hl = *(const LAS bf16x8*)(lds + R_LO + fr * R_STRIDE + k0 * 2);
#pragma unroll
              for (int nb = 0; nb < 2; ++nb) { const bf16x8 wh = *(const GAS bf16x8*)(RW + (size_t)(16 * nb + fr) * D + k0), wl = *(const GAS bf16x8*)(RW + (size_t)NE * D + (size_t)(16 * nb + fr) * D + k0);
                  acc[nb] = __builtin_amdgcn_mfma_f32_16x16x32_bf16(wh, hh, acc[nb], 0, 0, 0);
                  acc[nb] = __builtin_amdgcn_mfma_f32_16x16x32_bf16(wh, hl, acc[nb], 0, 0, 0);
                  acc[nb] = __builtin_amdgcn_mfma_f32_16x16x32_bf16(wl, hh, acc[nb], 0, 0, 0); } }
#pragma unroll
          for (int nb = 0; nb < 2; ++nb) *(LAS f32x4*)(lds + R_PL + w * 2048 + fr * 128 + (16 * nb + 4 * kq) * 4) = acc[nb]; }
        LDS_WAIT(); __syncthreads();
        { const int t = tid >> 5, e = tid & 31; float lg = A.in[25][e];
#pragma unroll
          for (int q = 0; q < 8; ++q) lg += *(const LAS float*)(lds + R_PL + q * 2048 + t * 128 + e * 4);
          *(LAS float*)(lds + R_LG + t * 128 + e * 4) = lg; }
        LDS_WAIT(); __syncthreads();
        if (tid < 16) { const int t = tile * 16 + tid; const LAS float* lg = (const LAS float*)(lds + R_LG + tid * 128);
            int idx[4]; float val[4]; unsigned used = 0u;
#pragma unroll
            for (int k = 0; k < 4; ++k) { int bi = 0; float bv = -INFINITY;
                for (int e = 0; e < NE; ++e) { const float x = lg[e]; if (!((used >> e) & 1u) && x > bv) { bv = x; bi = e; } }
                used |= 1u << bi; idx[k] = bi; val[k] = bv; }
            float ex[4], den = 0.f;
#pragma unroll
            for (int k = 0; k < 4; ++k) { ex[k] = __expf(val[k] - val[0]); den += ex[k]; }
            const float inv = 1.f / den;
            *(GAS v4i*)((int*)(A.ws + WS_TOPI) + t * 4) = (v4i){idx[0], idx[1], idx[2], idx[3]};
            *(GAS f32x4*)((float*)(A.ws + WS_TOPW) + t * 4) = (f32x4){ex[0] * inv, ex[1] * inv, ex[2] * inv, ex[3] * inv};
#pragma unroll
            for (int k = 0; k < 4; ++k) __hip_atomic_fetch_add((LAS int*)(lds + R_HIST + idx[k] * 4), 1, __ATOMIC_RELAXED, __HIP_MEMORY_SCOPE_WORKGROUP); }
        LDS_WAIT(); __syncthreads();
    }
    if (tid < 32) ((int*)(A.ws + WS_ROUTE))[blockIdx.x * NE + tid] = *(LAS int*)(lds + R_HIST + tid * 4);
}

__device__ __forceinline__ void p9_phase(const Args& A, const Frame& F) {
    LAS int* li = (LAS int*)F.lds;
    const int tid = ((int)threadIdx.x), lane = ((int)threadIdx.x & 63), me = blockIdx.x;
    const int* blk = (const int*)(A.ws + WS_ROUTE);
    { const int j = tid >> 5, e = tid & 31; int tot = 0, bef = 0;
      for (int b = j; b < F.G; b += 16) { const int c = blk[b * NE + e]; tot += c; bef += (b < me) ? c : 0; }
      li[j * 32 + e] = tot; li[512 + j * 32 + e] = bef; }
    __syncthreads();
    if (tid < 32) { int tot = 0, bef = 0; for (int j = 0; j < 16; ++j) { tot += li[j * 32 + tid]; bef += li[512 + j * 32 + tid]; } li[1024 + tid] = tot; li[1056 + tid] = bef; li[1152 + tid] = 0; }
    __syncthreads();
    if (tid == 0) { int a = 0; for (int e = 0; e < NE; ++e) { li[1088 + e] = a; a += (li[1024 + e] + 255) / 256 * 256; } li[1088 + NE] = a; }
    __syncthreads();
    int* srow = (int*)(A.ws + WS_SROW); int* pos_of = (int*)(A.ws + WS_POS); const int* topi = (const int*)(A.ws + WS_TOPI);
    if (F.wave == 0) {
        for (int tile = me; tile < T / 16; tile += F.G) {
            const int t = tile * 16 + (lane >> 2), ex = topi[t * 4 + (lane & 3)];
            int rank = 0, cnt_mine = 0;
            for (int e = 0; e < NE; ++e) { const unsigned long long m = __ballot(ex == e); if (ex == e) rank = __popcll(m & ((1ull << lane) - 1ull)); if (lane == e) cnt_mine = __popcll(m); }
            const int pos = li[1088 + ex] + li[1056 + ex] + li[1152 + ex] + rank;
            pos_of[t * 4 + (lane & 3)] = pos; srow[pos] = t;
            asm volatile("s_waitcnt lgkmcnt(0)" ::: "memory");
            if (lane < 32) li[1152 + lane] += cnt_mine;
            asm volatile("s_waitcnt lgkmcnt(0)" ::: "memory");
        }
    }
    for (int e = me; e < NE; e += F.G) { const int p0 = li[1088 + e] + li[1024 + e], p1 = li[1088 + e + 1]; for (int r = p0 + tid; r < p1; r += NTHREADS) srow[r] = 0; }
    if (me == 0) { if (tid <= NE) ((int*)(A.ws + WS_SEG))[tid] = li[1088 + tid];
        const int nt = li[1088 + NE] / 256; for (int r = tid; r < nt; r += NTHREADS) { int e = 0; for (int j = 1; j < NE; ++j) e = (r * 256 >= li[1088 + j]) ? j : e; ((int*)(A.ws + WS_TE))[r] = e; } }
    __syncthreads();
}

struct MoeOrder1 {
    const char* H2; const char* W1T; const int* srow; const int* te; int NT, G, c;
    __device__ __forceinline__ bool next(int i, pg8::Unit& u) const {
        const int L = i * G + c, rt = L >> 3, ct = L & 7; if (rt >= NT) return false;
        const int e = te[rt]; u.pm = rt; u.pn = ct; u.aux = e; u.abase = H2;
        u.b0 = W1T + ((size_t)e * 2 * DE + ct * 128) * D * 2; u.b1 = u.b0 + (size_t)DE * D * 2; return true;
    }
    static constexpr bool GATHER = true;
    __device__ __forceinline__ void aoff(const pg8::Unit& u, const int (&R)[2], const int (&C)[2], unsigned (&va)[2][2]) const {
#pragma unroll
        for (int h = 0; h < 2; ++h)
#pragma unroll
            for (int i = 0; i < 2; ++i) va[h][i] = (unsigned)(srow[u.pm * 256 + h * 128 + R[i]] * D + C[i]) * 2u;
    }
};
struct EpiSwiglu {
    static constexpr bool PERM = true;
    const float* b_in; bf16* ACT;
    __device__ __forceinline__ void operator()(const pg8::f32x4 (&acc)[2][2][4][2], const pg8::Unit& u, int wr, int wc, int fr, int fq) const {
        const int row0 = u.pm * 256 + wr * 64 + fr, col = u.pn * 128 + wc * 32 + 8 * fq;
        const float* bi = b_in + (size_t)u.aux * 2 * DE + col;
        const f32x4 bg0 = *(const GAS f32x4*)bi, bg1 = *(const GAS f32x4*)(bi + 4), bu0 = *(const GAS f32x4*)(bi + DE), bu1 = *(const GAS f32x4*)(bi + DE + 4);
#pragma unroll
        for (int ai = 0; ai < 2; ++ai)
#pragma unroll
            for (int m = 0; m < 4; ++m) { float o[8];
#pragma unroll
                for (int j = 0; j < 8; ++j) { const float gt = fminf(acc[ai][0][m][j >> 2][j & 3] + (j < 4 ? bg0[j & 3] : bg1[j & 3]), 7.f);
                    const float up = fminf(fmaxf(acc[ai][1][m][j >> 2][j & 3] + (j < 4 ? bu0[j & 3] : bu1[j & 3]), -7.f), 7.f);
                    o[j] = (up + 1.f) * (gt * sigm(1.702f * gt)); }
                *(GAS v4u*)(ACT + (size_t)(row0 + ai * 128 + m * 16) * DE + col) = (v4u){pk2(o[0], o[1]), pk2(o[2], o[3]), pk2(o[4], o[5]), pk2(o[6], o[7])}; }
    }
};
__device__ __forceinline__ void p10_phase(const Args& A, const Frame& F) {
    const int NT = ((const int*)(A.ws + WS_SEG))[NE] / 256;
    MoeOrder1 S{(const char*)(A.ws + WS_H2), (const char*)(A.ws + WS_W1T), (const int*)(A.ws + WS_SROW), (const int*)(A.ws + WS_TE), NT, F.G, F.vcu};
    EpiSwiglu E{A.in[27], (bf16*)(A.ws + WS_RX)};
    pg8::gemm_phase<EpiSwiglu, MoeOrder1>(F.lds, D, S, E);
}
struct MoeOrder2 {
    const char* ACT; const char* W2T; const int* te; int NT, G, c;
    __device__ __forceinline__ bool next(int i, pg8::Unit& u) const {
        const int L = i * G + c, rt = L >> 2, ct = L & 3; if (rt >= NT) return false;
        const int e = te[rt]; u.pm = rt; u.pn = ct; u.aux = e; u.abase = ACT + (size_t)rt * 256 * DE * 2;
        u.b0 = W2T + ((size_t)e * D + ct * 256) * DE * 2; u.b1 = u.b0 + (size_t)128 * DE * 2; return true;
    }
    static constexpr bool GATHER = false;
    __device__ __forceinline__ void aoff(const pg8::Unit&, const int (&R)[2], const int (&C)[2], unsigned (&va)[2][2]) const {
#pragma unroll
        for (int h = 0; h < 2; ++h)
#pragma unroll
            for (int i = 0; i < 2; ++i) va[h][i] = (unsigned)((h * 128 + R[i]) * DE + C[i]) * 2u;
    }
};
struct EpiMoe2 {
    static constexpr bool PERM = true;
    const float* b_out; bf16* YS;
    __device__ __forceinline__ void operator()(const pg8::f32x4 (&acc)[2][2][4][2], const pg8::Unit& u, int wr, int wc, int fr, int fq) const {
        const int row0 = u.pm * 256 + wr * 64 + fr, col0 = u.pn * 256 + wc * 32 + 8 * fq;
#pragma unroll
        for (int bj = 0; bj < 2; ++bj) { const int col = col0 + bj * 128; const float* bo = b_out + (size_t)u.aux * D + col;
            const f32x4 b0 = *(const GAS f32x4*)bo, b1 = *(const GAS f32x4*)(bo + 4);
#pragma unroll
            for (int ai = 0; ai < 2; ++ai)
#pragma unroll
                for (int m = 0; m < 4; ++m) { const pg8::f32x4 a0 = acc[ai][bj][m][0] + b0, a1 = acc[ai][bj][m][1] + b1;
                    *(GAS v4u*)(YS + (size_t)(row0 + ai * 128 + m * 16) * D + col) = (v4u){pk2(a0[0], a0[1]), pk2(a0[2], a0[3]), pk2(a1[0], a1[1]), pk2(a1[2], a1[3])}; } }
    }
};
__device__ __forceinline__ void p11_phase(const Args& A, const Frame& F) {
    const int NT = ((const int*)(A.ws + WS_SEG))[NE] / 256;
    MoeOrder2 S{(const char*)(A.ws + WS_RX), (const char*)(A.ws + WS_W2T), (const int*)(A.ws + WS_TE), NT, F.G, F.vcu};
    EpiMoe2 E{A.in[29], (bf16*)(A.ws + WS_RY)};
    pg8::gemm_phase<EpiMoe2, MoeOrder2>(F.lds, DE, S, E);
}
__device__ __forceinline__ void p12_phase(const Args& A, const Frame& F) {
    const int gw = F.vcu * NWAVES + F.wave, NGW = F.G * NWAVES, lane = ((int)threadIdx.x & 63);
    const float* mod = (const float*)(A.ws + WS_MOD); const float* X1 = (const float*)(A.ws + WS_X1); const bf16* YS = (const bf16*)(A.ws + WS_RY);
    for (int t = gw; t < T; t += NGW) { const int b = t / SEQ;
        const v4i ps = *(const GAS v4i*)((const int*)(A.ws + WS_POS) + t * 4); const f32x4 wt = *(const GAS f32x4*)((const float*)(A.ws + WS_TOPW) + t * 4);
        const int pp[4] = {ps.x, ps.y, ps.z, ps.w};
        f32x4 o[4]; float s = 0.f;
#pragma unroll
        for (int j = 0; j < 4; ++j) { f32x4 m = {0.f, 0.f, 0.f, 0.f};
#pragma unroll
            for (int k = 0; k < 4; ++k) { const v2u y = ((const GAS v2u*)(YS + (size_t)pp[k] * D))[lane + 64 * j]; const float wk = wt[k];
                m[0] += wk * bflo(y.x); m[1] += wk * bfhi(y.x); m[2] += wk * bflo(y.y); m[3] += wk * bfhi(y.y); }
            const f32x4 xv = ((const GAS f32x4*)(X1 + (size_t)t * D))[lane + 64 * j], g2 = ((const GAS f32x4*)(mod + b * (NMOD * D) + 5 * D))[lane + 64 * j];
            o[j] = xv + g2 * m; s += (o[j].x * o[j].x + o[j].y * o[j].y) + (o[j].z * o[j].z + o[j].w * o[j].w); }
        const float r = rsqrtf(wave_sum(s) * (1.f / D) + EPS);
#pragma unroll
        for (int j = 0; j < 4; ++j) { const f32x4 fg = ((const GAS f32x4*)A.in[30])[lane + 64 * j]; ((GAS f32x4*)(A.out + (size_t)t * D))[lane + 64 * j] = o[j] * r * fg; }
    }
}
constexpr int NPHASE = 13;
__global__ void __launch_bounds__(NTHREADS, 2) mega(Args args) {
    extern __shared__ __attribute__((aligned(16))) unsigned char lds_[];
    Frame F;
    F.lds = (LAS unsigned char*)lds_;
    F.wave = __builtin_amdgcn_readfirstlane((int)threadIdx.x >> 6);
    F.G = gridDim.x; { const int bx = blockIdx.x; F.vcu = (F.G % 8 == 0) ? (bx % 8) * (F.G / 8) + bx / 8 : bx; }
    for (int u = threadIdx.x; u < (LDS_BYTES - LDSCTL_OFF) / 4; u += NTHREADS) ((LAS unsigned*)(F.lds + LDSCTL_OFF))[u] = 0u;
    __syncthreads();
    XcdBarrier bar = xcd_barrier_post((unsigned*)(args.ws + WS_CTL) + CW_BAR, (volatile LAS unsigned*)(F.lds + MISC_OFF) + 8);
    const int lo = args.ph_lo, hi = args.ph_hi;
#define IN(k) (lo <= (k) && (k) < hi)
#define SEAM(k) do { if (IN(k) && IN((k) + 1)) xcd_barrier(bar); } while (0)
    if (IN(0)) { p0_prologue(args, F); } SEAM(0);
    if (IN(1)) { p1_h1(args, F); } SEAM(1);
    if (IN(2)) { p2_proj(args, F); } SEAM(2);
    if (IN(3)) { p3_phase(args, F); } SEAM(3);
    if (IN(4)) { p4_phase(args, F); } SEAM(4);
    if (IN(5)) { p5_phase(args, F); } SEAM(5);
    if (IN(6)) { p6_phase(args, F); } SEAM(6);
    if (IN(7)) { p7_phase(args, F); } SEAM(7);
    if (IN(8)) { p8_phase(args, F); } SEAM(8);
    if (IN(9)) { p9_phase(args, F); } SEAM(9);
    if (IN(10)) { p10_phase(args, F); } SEAM(10);
    if (IN(11)) { p11_phase(args, F); } SEAM(11);
    if (IN(12)) { p12_phase(args, F); }
#undef IN
#undef SEAM
}
}
namespace nv {

__device__ __forceinline__ float sigmoidf_(float x) { return 1.f / (1.f + __expf(-x)); }
__device__ __forceinline__ float gelu_tanh(float x) { const float u = 0.7978845608028654f * (x + 0.044715f * x * x * x); return 0.5f * x * (1.f + tanhf(u)); }

__device__ __forceinline__ float block_sum_256(float v, float* sm) {
#pragma unroll
    for (int o = 32; o > 0; o >>= 1) v += __shfl_xor(v, o);
    __syncthreads();
    if ((threadIdx.x & 63) == 0) sm[threadIdx.x >> 6] = v;
    __syncthreads();
    return sm[0] + sm[1] + sm[2] + sm[3];
}

__global__ void k_mod(const float* __restrict__ c, const float* __restrict__ ada_w, const float* __restrict__ ada_b, float* __restrict__ mod) {
    const int j = blockIdx.x * blockDim.x + threadIdx.x, b = blockIdx.y;
    float acc = ada_b[j];
    for (int k = 0; k < D; ++k) { const float cv = c[b * D + k]; acc += cv * sigmoidf_(cv) * ada_w[(size_t)k * (NMOD * D) + j]; }
    mod[b * (NMOD * D) + j] = acc;
}

__global__ void k_norm_mod(const float* __restrict__ x, const float* __restrict__ g, const float* __restrict__ mod, int shift_off, int scale_off, float* __restrict__ h) {
    __shared__ float sm[8];
    const int t = blockIdx.x, b = t / SEQ;
    const float4 v = ((const float4*)(x + (size_t)t * D))[threadIdx.x];
    const float ss = block_sum_256(v.x * v.x + v.y * v.y + v.z * v.z + v.w * v.w, sm);
    const float r = rsqrtf(ss * (1.f / D) + EPS);
    const int d0 = threadIdx.x * 4;
    const float* mb = mod + b * (NMOD * D);
    float o[4] = {v.x, v.y, v.z, v.w};
#pragma unroll
    for (int i = 0; i < 4; ++i) o[i] = o[i] * r * g[d0 + i] * (1.f + mb[scale_off + d0 + i]) + mb[shift_off + d0 + i];
    ((float4*)(h + (size_t)t * D))[threadIdx.x] = make_float4(o[0], o[1], o[2], o[3]);
}

template <bool DUAL, class AF, class EF>
__device__ __forceinline__ void sgemm_tile(int m0, int n0, int K, const float* __restrict__ Bm, int ldb, int dual_off, AF af, EF ef) {
    __shared__ float As[16][68], Bs[16][68], Bs2[DUAL ? 16 : 1][68];
    const int tid = threadIdx.x, tx = tid & 15, ty = tid >> 4;
    float acc[4][4], acc2[4][4];
#pragma unroll
    for (int i = 0; i < 4; ++i)
#pragma unroll
        for (int j = 0; j < 4; ++j) { acc[i][j] = 0.f; acc2[i][j] = 0.f; }
    for (int k0 = 0; k0 < K; k0 += 16) {
#pragma unroll
        for (int q = 0; q < 4; ++q) { const int idx = tid + q * 256, m = idx >> 4, k = idx & 15; As[k][m] = af(m0 + m, k0 + k); }
#pragma unroll
        for (int q = 0; q < 4; ++q) { const int idx = tid + q * 256, k = idx >> 6, n = idx & 63; Bs[k][n] = Bm[(size_t)(k0 + k) * ldb + n0 + n];
            if (DUAL) Bs2[k][n] = Bm[(size_t)(k0 + k) * ldb + n0 + n + dual_off]; }
        __syncthreads();
#pragma unroll
        for (int k = 0; k < 16; ++k) {
            float a[4], b[4], b2[4];
#pragma unroll
            for (int i = 0; i < 4; ++i) a[i] = As[k][ty * 4 + i];
#pragma unroll
            for (int j = 0; j < 4; ++j) { b[j] = Bs[k][tx * 4 + j]; b2[j] = DUAL ? Bs2[k][tx * 4 + j] : 0.f; }
#pragma unroll
            for (int i = 0; i < 4; ++i)
#pragma unroll
                for (int j = 0; j < 4; ++j) { acc[i][j] += a[i] * b[j]; if (DUAL) acc2[i][j] += a[i] * b2[j]; }
        }
        __syncthreads();
    }
#pragma unroll
    for (int i = 0; i < 4; ++i)
#pragma unroll
        for (int j = 0; j < 4; ++j) ef(m0 + ty * 4 + i, n0 + tx * 4 + j, acc[i][j], acc2[i][j]);
}

__global__ void k_gemm_plain(const float* __restrict__ A, int lda, const float* __restrict__ Bm, int ldb, float* __restrict__ C, int ldc, int K) {
    const int m0 = blockIdx.y * 64, n0 = blockIdx.x * 64;
    sgemm_tile<false>(m0, n0, K, Bm, ldb, 0, [&](int m, int k) { return A[(size_t)m * lda + k]; },
                      [&](int m, int n, float a, float) { C[(size_t)m * ldc + n] = a; });
}
__global__ void k_gemm_glu(const float* __restrict__ Z, const float* __restrict__ W, const float* __restrict__ bias, float* __restrict__ O) {
    const int m0 = blockIdx.y * 64, n0 = blockIdx.x * 64;
    sgemm_tile<false>(m0, n0, SW, W, SW, 0, [&](int m, int k) { return Z[(size_t)m * SW + k]; },
                      [&](int m, int n, float a, float) { O[(size_t)m * SW + n] = Z[(size_t)m * SW + n] * sigmoidf_(a + bias[n]); });
}
template <bool PRE> __global__ void k_gemm_branch(const float* __restrict__ A, const float* __restrict__ W, const float* __restrict__ proj, int gate_off, float* __restrict__ merged, int accumulate) {
    const int m0 = blockIdx.y * 64, n0 = blockIdx.x * 64;
    sgemm_tile<false>(m0, n0, SW, W, D, 0, [&](int m, int k) { return A[(size_t)m * SW + k]; },
                      [&](int m, int n, float a, float) { const float gv = proj[(size_t)m * PW + gate_off + n]; const float v = (PRE ? gv : sigmoidf_(gv)) * a;
                          float* p = merged + (size_t)m * D + n; *p = accumulate ? (*p + v) : v; });
}
__global__ void k_gemm_out(const float* __restrict__ merged, const float* __restrict__ W, const float* __restrict__ x, const float* __restrict__ mod, float* __restrict__ x1) {
    const int m0 = blockIdx.y * 64, n0 = blockIdx.x * 64;
    sgemm_tile<false>(m0, n0, D, W, D, 0, [&](int m, int k) { return merged[(size_t)m * D + k]; },
                      [&](int m, int n, float a, float) { const int b = m / SEQ; x1[(size_t)m * D + n] = x[(size_t)m * D + n] + mod[b * (NMOD * D) + 2 * D + n] * a; });
}

__global__ void k_s5(const float* __restrict__ proj, const float* __restrict__ a_re, const float* __restrict__ a_im, const float* __restrict__ log_dt,
                     const float* __restrict__ b_re, const float* __restrict__ b_im, const float* __restrict__ c_re, const float* __restrict__ c_im,
                     const float* __restrict__ dskip, float* __restrict__ z) {
    __shared__ float s_re[64], s_im[64], cre[16][65], cim[16][65];
    const int p = threadIdx.x, b = blockIdx.x / NG, g = blockIdx.x % NG;
    const double dt = exp((double)log_dt[g]);
    const double lr = a_re[g * NP + p], li = a_im[g * NP + p];
    const double mag = exp(lr * dt), lbr_d = mag * cos(li * dt), lbi_d = mag * sin(li * dt);
    const double nr = lbr_d - 1.0, ni = lbi_d, den = lr * lr + li * li;
    const double cfr = (nr * lr + ni * li) / den, cfi = (ni * lr - nr * li) / den;
    const float lbr = (float)lbr_d, lbi = (float)lbi_d;
    float bbr[16], bbi[16];
#pragma unroll
    for (int h = 0; h < 16; ++h) { const double br = b_re[(g * NP + p) * NHC + h], bi = b_im[(g * NP + p) * NHC + h];
        bbr[h] = (float)(cfr * br - cfi * bi); bbi[h] = (float)(cfr * bi + cfi * br); }
    for (int i = p; i < 16 * 64; i += 64) { const int ho = i / 64, pp = i % 64; cre[ho][pp] = c_re[(g * NHC + ho) * NP + pp]; cim[ho][pp] = c_im[(g * NHC + ho) * NP + pp]; }
    __syncthreads();
    float sr = 0.f, si = 0.f;
    const float dsk = (p < 16) ? dskip[g * NHC + p] : 0.f;
    for (int s = 0; s < SEQ; ++s) {
        const size_t t = (size_t)b * SEQ + s;
        const float4* up = (const float4*)(proj + t * PW + g * NHC);
        const float4 u0 = up[0], u1 = up[1], u2 = up[2], u3 = up[3];
        const float u[16] = {u0.x, u0.y, u0.z, u0.w, u1.x, u1.y, u1.z, u1.w, u2.x, u2.y, u2.z, u2.w, u3.x, u3.y, u3.z, u3.w};
        float br = 0.f, bi = 0.f;
#pragma unroll
        for (int h = 0; h < 16; ++h) { br += bbr[h] * u[h]; bi += bbi[h] * u[h]; }
        const float nsr = lbr * sr - lbi * si + br, nsi = lbr * si + lbi * sr + bi;
        sr = nsr; si = nsi;
        s_re[p] = sr; s_im[p] = si;
        __syncthreads();
        if (p < 16) {
            float y = 0.f;
            for (int pp = 0; pp < 64; ++pp) y += cre[p][pp] * s_re[pp] - cim[p][pp] * s_im[pp];
            float up_ = 0.f;
#pragma unroll
            for (int h = 0; h < 16; ++h) up_ = (h == p) ? u[h] : up_;
            y += dsk * up_;
            z[t * SW + g * NHC + p] = gelu_tanh(y);
        }
        __syncthreads();
    }
}

template <bool PRE> __global__ void k_gmlp_ln(const float* __restrict__ proj, const float* __restrict__ lng, const float* __restrict__ lnb, float* __restrict__ gu, float* __restrict__ vn) {
    __shared__ float sm[8];
    const int t = blockIdx.x, i0 = threadIdx.x * 2;
    const float* pr = proj + (size_t)t * PW + SW;
    const float a0 = PRE ? pr[i0] : gelu_tanh(pr[i0]), a1 = PRE ? pr[i0 + 1] : gelu_tanh(pr[i0 + 1]);
    const float v0 = PRE ? pr[GW + i0] : gelu_tanh(pr[GW + i0]), v1 = PRE ? pr[GW + i0 + 1] : gelu_tanh(pr[GW + i0 + 1]);
    gu[(size_t)t * GW + i0] = a0; gu[(size_t)t * GW + i0 + 1] = a1;
    const float mu = block_sum_256(v0 + v1, sm) * (1.f / GW);
    const float d0 = v0 - mu, d1 = v1 - mu;
    const float var = block_sum_256(d0 * d0 + d1 * d1, sm) * (1.f / GW);
    const float r = rsqrtf(var + EPS);
    vn[(size_t)t * GW + i0] = d0 * r * lng[i0] + lnb[i0];
    vn[(size_t)t * GW + i0 + 1] = d1 * r * lng[i0 + 1] + lnb[i0 + 1];
}
__global__ void k_gmlp_mix(const float* __restrict__ gu, const float* __restrict__ vn, const float* __restrict__ ws, const float* __restrict__ bs, float* __restrict__ gm) {
    const int blk = blockIdx.x, sub = blk & 31, h = (blk >> 5) & 7, chunk = blk >> 8;
    const int tl = sub * 4 + (threadIdx.x >> 6), c = threadIdx.x & 63;
    const float* w = ws + ((size_t)h * CHUNK + tl) * CHUNK;
    const float* v = vn + (size_t)chunk * CHUNK * GW + h * HD + c;
    float acc = 0.f;
    for (int s = 0; s <= tl; ++s) acc += w[s] * v[(size_t)s * GW];
    const size_t o = ((size_t)chunk * CHUNK + tl) * GW + h * HD + c;
    gm[o] = gu[o] * (acc + bs[h * CHUNK + tl]);
}

__global__ void k_router(const float* __restrict__ x1, const float* __restrict__ g2, const float* __restrict__ mod, const float* __restrict__ rw, const float* __restrict__ rb,
                         float* __restrict__ h2, int* __restrict__ topi, float* __restrict__ topw) {
    __shared__ float sm[8], hs[D], part[8][32], lg[32];
    const int t = blockIdx.x, b = t / SEQ;
    const float4 v = ((const float4*)(x1 + (size_t)t * D))[threadIdx.x];
    const float ss = block_sum_256(v.x * v.x + v.y * v.y + v.z * v.z + v.w * v.w, sm);
    const float r = rsqrtf(ss * (1.f / D) + EPS);
    const int d0 = threadIdx.x * 4;
    const float* mb = mod + b * (NMOD * D);
    float o[4] = {v.x, v.y, v.z, v.w};
#pragma unroll
    for (int i = 0; i < 4; ++i) { o[i] = o[i] * r * g2[d0 + i] * (1.f + mb[4 * D + d0 + i]) + mb[3 * D + d0 + i]; hs[d0 + i] = o[i]; }
    ((float4*)(h2 + (size_t)t * D))[threadIdx.x] = make_float4(o[0], o[1], o[2], o[3]);
    __syncthreads();
    { const int e = threadIdx.x & 31, q = threadIdx.x >> 5; float a = 0.f;
      for (int k = q * 128; k < q * 128 + 128; ++k) a += hs[k] * rw[k * NE + e];
      part[q][e] = a; }
    __syncthreads();
    if (threadIdx.x < 32) { float a = rb[threadIdx.x]; for (int q = 0; q < 8; ++q) a += part[q][threadIdx.x]; lg[threadIdx.x] = a; }
    __syncthreads();
    if (threadIdx.x == 0) {
        int idx[4]; float val[4]; unsigned used = 0u;
        for (int k = 0; k < 4; ++k) { int bi = -1; float bv = -INFINITY; for (int e = 0; e < NE; ++e) if (!((used >> e) & 1u) && lg[e] > bv) { bv = lg[e]; bi = e; } used |= 1u << bi; idx[k] = bi; val[k] = bv; }
        float den = 0.f, ex[4];
        for (int k = 0; k < 4; ++k) { ex[k] = __expf(val[k] - val[0]); den += ex[k]; }
        for (int k = 0; k < 4; ++k) { topi[t * 4 + k] = idx[k]; topw[t * 4 + k] = ex[k] / den; }
    }
}

__global__ void k_route(const int* __restrict__ topi, const float* __restrict__ topw, int* __restrict__ seg, int* __restrict__ srow_tok, float* __restrict__ srow_w, int* __restrict__ pos_of) {
    __shared__ int cnt[NE], st[NE + 1];
    const int e = threadIdx.x;
    int c = 0;
    for (int i = 0; i < T * TOPK; ++i) c += (topi[i] == e);
    cnt[e] = c;
    __syncthreads();
    if (e == 0) { int a = 0; for (int j = 0; j < NE; ++j) { st[j] = a; a += (cnt[j] + 255) / 256 * 256; } st[NE] = a; }
    __syncthreads();
    seg[e] = st[e]; if (e == 0) seg[NE] = st[NE];
    int pos = st[e];
    for (int i = 0; i < T * TOPK; ++i) if (topi[i] == e) { srow_tok[pos] = i >> 2; srow_w[pos] = topw[i]; pos_of[i] = pos; ++pos; }
}

__device__ __forceinline__ int find_expert(const int* __restrict__ seg, int row) { int e = 0; for (int j = 1; j < NE; ++j) e = (row >= seg[j]) ? j : e; return e; }

__global__ void k_moe1(const float* __restrict__ h2, const int* __restrict__ seg, const int* __restrict__ srow_tok, const float* __restrict__ w_in, const float* __restrict__ b_in, float* __restrict__ act) {
    const int m0 = blockIdx.y * 64, n0 = blockIdx.x * 64;
    if (m0 >= seg[NE]) return;
    const int e = find_expert(seg, m0);
    const float* W = w_in + (size_t)e * D * 2 * DE; const float* bi = b_in + (size_t)e * 2 * DE;
    sgemm_tile<true>(m0, n0, D, W, 2 * DE, DE, [&](int m, int k) { const int tk = srow_tok[m]; return tk >= 0 ? h2[(size_t)tk * D + k] : 0.f; },
                     [&](int m, int n, float ag, float au) { float gt = fminf(ag + bi[n], 7.f); float up = fminf(fmaxf(au + bi[DE + n], -7.f), 7.f);
                         act[(size_t)m * DE + n] = (up + 1.f) * (gt * sigmoidf_(1.702f * gt)); });
}
__global__ void k_moe2(const float* __restrict__ act, const int* __restrict__ seg, const float* __restrict__ srow_w, const float* __restrict__ w_out, const float* __restrict__ b_out, float* __restrict__ ys) {
    const int m0 = blockIdx.y * 64, n0 = blockIdx.x * 64;
    if (m0 >= seg[NE]) return;
    const int e = find_expert(seg, m0);
    const float* W = w_out + (size_t)e * DE * D; const float* bo = b_out + (size_t)e * D;
    sgemm_tile<false>(m0, n0, DE, W, D, 0, [&](int m, int k) { return act[(size_t)m * DE + k]; },
                      [&](int m, int n, float a, float) { ys[(size_t)m * D + n] = (a + bo[n]) * srow_w[m]; });
}
__global__ void k_final(const float* __restrict__ x1, const float* __restrict__ ys, const int* __restrict__ pos_of, const float* __restrict__ mod, const float* __restrict__ fg, float* __restrict__ out) {
    __shared__ float sm[8];
    const int t = blockIdx.x, b = t / SEQ, d0 = threadIdx.x * 4;
    const float4 xv = ((const float4*)(x1 + (size_t)t * D))[threadIdx.x];
    float m[4] = {0.f, 0.f, 0.f, 0.f};
    for (int k = 0; k < 4; ++k) { const float4 y = ((const float4*)(ys + (size_t)pos_of[t * 4 + k] * D))[threadIdx.x]; m[0] += y.x; m[1] += y.y; m[2] += y.z; m[3] += y.w; }
    const float* g2 = mod + b * (NMOD * D) + 5 * D + d0;
    float o[4] = {xv.x + g2[0] * m[0], xv.y + g2[1] * m[1], xv.z + g2[2] * m[2], xv.w + g2[3] * m[3]};
    const float ss = block_sum_256(o[0] * o[0] + o[1] * o[1] + o[2] * o[2] + o[3] * o[3], sm);
    const float r = rsqrtf(ss * (1.f / D) + EPS);
    ((float4*)(out + (size_t)t * D))[threadIdx.x] = make_float4(o[0] * r * fg[d0], o[1] * r * fg[d0 + 1], o[2] * r * fg[d0 + 2], o[3] * r * fg[d0 + 3]);
}

__global__ void k_bf16_to_f32(const unsigned short* __restrict__ s, float* __restrict__ d, size_t n) { for (size_t i = (size_t)blockIdx.x * blockDim.x + threadIdx.x; i < n; i += (size_t)gridDim.x * blockDim.x) d[i] = __builtin_bit_cast(float, (unsigned)s[i] << 16); }
}
static int launch_mega(const Args& a0, int lo, int hi, hipStream_t stream) {
    static int grid = 0;
    if (grid == 0) {
        int dev = 0, cus = 0, per_cu = 0;
        if (hipGetDevice(&dev) != hipSuccess || hipDeviceGetAttribute(&cus, hipDeviceAttributeMultiprocessorCount, dev) != hipSuccess) { fprintf(stderr, "kernel_launch: device query failed\n"); grid = -1; return -1; }
        if (hipFuncSetAttribute((const void*)mega, hipFuncAttributeMaxDynamicSharedMemorySize, LDS_BYTES) != hipSuccess) { fprintf(stderr, "kernel_launch: hipFuncSetAttribute failed\n"); grid = -1; return -1; }
        if (hipOccupancyMaxActiveBlocksPerMultiprocessor(&per_cu, (const void*)mega, NTHREADS, LDS_BYTES) != hipSuccess || per_cu < 1) { fprintf(stderr, "kernel_launch: occupancy query says %d blocks per CU\n", per_cu); per_cu = 1; }
        (void)hipGetLastError();
        grid = cus;
    }
    if (grid < 0) return -1;
    Args a = a0; a.ph_lo = lo; a.ph_hi = hi;
    hipLaunchKernelGGL(mega, dim3(grid), dim3(NTHREADS), LDS_BYTES, stream, a);
    return 0;
}

extern "C" void kernel_launch(void* const* d_in, const int* in_sizes, int n_in, void* d_out, int out_size, void* d_ws, size_t ws_size, hipStream_t stream) {
    if (n_in != 31 || ws_size < 1000 * MiB) { fprintf(stderr, "kernel_launch: unexpected inputs (n_in %d, ws %zu)\n", n_in, ws_size); return; }
    Args a{};
    for (int i = 0; i < 31; ++i) a.in[i] = (const float*)d_in[i];
    a.out = (float*)d_out; a.ws = (unsigned char*)d_ws;
    (void)hipMemsetAsync((char*)d_ws + WS_CTL, 0, CTL_ZERO_BYTES, stream);
    char* ws = (char*)d_ws;
    const float* x = a.in[0];
    float* out = (float*)d_out;
    launch_mega(a, 0, NPHASE, stream);
}
```

```cpp
#include <hip/hip_runtime.h>
#include <cstdio>
#include <cstdint>
namespace pg8 {
#define PG8_LAS __attribute__((address_space(3)))
typedef unsigned short bf16_t;
typedef short bf16x8 __attribute__((ext_vector_type(8)));
typedef float f32x4 __attribute__((ext_vector_type(4)));
typedef float f32x2 __attribute__((ext_vector_type(2)));
typedef unsigned u32x4 __attribute__((ext_vector_type(4)));
typedef unsigned u32x2 __attribute__((ext_vector_type(2)));
constexpr int BM = 256, BK = 64, HALF = 128, HTB = HALF * BK * 2  , STAGE_BYTES = 8 * HTB, NXCD = 8, WGM = 8;
constexpr int VN_SLOT_OFF = STAGE_BYTES + 1024;

__host__ __device__ __forceinline__ int lds_byte(int r, int c) { const int st = (r >> 4) * 2 + (c >> 5), rr = r & 15, cc = c & 31, ob = rr * 64 + cc * 2; return st * 1024 + (ob ^ (((ob >> 9) & 1) << 5)); }
__host__ __device__ __forceinline__ void stage_rc(int b, int& R, int& C) { const int st = b / 1024, sb = b % 1024, swz = sb ^ (((sb >> 9) & 1) << 5); R = (st >> 1) * 16 + swz / 64; C = (st & 1) * 32 + (swz % 64) / 2; }
__host__ __device__ __forceinline__ int perm32(int rho) { const int n = rho >> 4, i = rho & 15; return 8 * (i >> 2) + 4 * n + (i & 3); }

struct Unit { int pm, pn, aux; const char* abase; const char* b0; const char* b1; };

__device__ __forceinline__ unsigned cvt_pk_bf16(float lo, float hi) { unsigned r; asm volatile("v_cvt_pk_bf16_f32 %0, %1, %2" : "=v"(r) : "v"(lo), "v"(hi)); return r; }

template <class Epi, class Sched>
__device__ __forceinline__ void gemm_phase(PG8_LAS unsigned char* lds, const int K, const Sched& S, const Epi& E) {
    const int tid = threadIdx.x, wid = __builtin_amdgcn_readfirstlane(tid >> 6), lane = tid & 63, wr = wid >> 2, wc = wid & 3, fr = lane & 15, fq = lane >> 4;
    const int nt = K / BK;
    int Rp[2], Cp[2]; unsigned voffB[2];
#pragma unroll
    for (int i = 0; i < 2; ++i) { int R, C; stage_rc(tid * 16 + i * 8192, R, C); Rp[i] = R; Cp[i] = C; const int Rb = Epi::PERM ? ((R & ~31) + perm32(R & 31)) : R; voffB[i] = (unsigned)(Rb * K + C) * 2u; }
    const size_t kstep = (size_t)(BK * 2);
    const unsigned ldsw = (unsigned)wid * 1024u;
    const int aoff = lds_byte(wr * 64 + fr, fq * 8), boff = lds_byte(wc * 32 + fr, fq * 8);
#define PG8_SA(b, h) (((b) * 2 + (h)) * HTB)
#define PG8_SB(b, h) ((4 + (b) * 2 + (h)) * HTB)
#define PG8_STAGE(bufoff, gbase, voff) do { _Pragma("unroll") for (int _i = 0; _i < 2; ++_i) \
        __builtin_amdgcn_global_load_lds((const unsigned*)((const char*)(gbase) + (voff)[_i]), (PG8_LAS unsigned*)(lds + (bufoff) + ldsw + _i * 8192), 16, 0, 0); } while (0)
#define PG8_LDA(dst, b, h) do { _Pragma("unroll") for (int m = 0; m < 4; ++m) _Pragma("unroll") for (int k = 0; k < 2; ++k) dst[m][k] = *(const PG8_LAS bf16x8*)(lds + PG8_SA(b, h) + aoff + m * 2048 + k * 1024); } while (0)
#define PG8_LDB(dst, b, h) do { _Pragma("unroll") for (int n = 0; n < 2; ++n) _Pragma("unroll") for (int k = 0; k < 2; ++k) dst[n][k] = *(const PG8_LAS bf16x8*)(lds + PG8_SB(b, h) + boff + n * 2048 + k * 1024); } while (0)
#define PG8_MMA(ai, bj, At, Bt) do { __builtin_amdgcn_s_setprio(1); _Pragma("unroll") for (int m = 0; m < 4; ++m) _Pragma("unroll") for (int n = 0; n < 2; ++n) _Pragma("unroll") for (int k = 0; k < 2; ++k) \
        acc[ai][bj][m][n] = __builtin_amdgcn_mfma_f32_16x16x32_bf16(Bt[n][k], At[m][k], acc[ai][bj][m][n], 0, 0, 0); __builtin_amdgcn_s_setprio(0); } while (0)
#define PG8_WAIT_V(n) asm volatile("s_waitcnt vmcnt(" #n ")" ::: "memory")
#define PG8_WAIT_L(n) asm volatile("s_waitcnt lgkmcnt(" #n ")" ::: "memory")
#define PG8_BAR __builtin_amdgcn_s_barrier()
#define PG8_SCHED __builtin_amdgcn_sched_barrier(0)
    Unit cur, nxt; int ui = 0;
    if (!S.next(0, cur)) return;
    f32x4 acc[2][2][4][2];
#pragma unroll
    for (int a = 0; a < 2; ++a)
#pragma unroll
        for (int b = 0; b < 2; ++b)
#pragma unroll
            for (int m = 0; m < 4; ++m)
#pragma unroll
                for (int n = 0; n < 2; ++n) acc[a][b][m][n] = (f32x4){0.f, 0.f, 0.f, 0.f};
    bf16x8 At[4][2], B0[2][2], B1[2][2];
    unsigned va[2][2];
    PG8_LAS u32x4* vslot = (PG8_LAS u32x4*)(lds + VN_SLOT_OFF) + tid;
    S.aoff(cur, Rp, Cp, va);
    const char* cA = cur.abase; const char* cB0 = cur.b0; const char* cB1 = cur.b1;
    PG8_STAGE(PG8_SB(0, 0), cB0, voffB); PG8_STAGE(PG8_SB(0, 1), cB1, voffB); PG8_STAGE(PG8_SA(0, 0), cA, va[0]); PG8_STAGE(PG8_SA(0, 1), cA, va[1]);
    if (wr == 1) PG8_BAR;
    PG8_WAIT_V(2); PG8_BAR;
    PG8_STAGE(PG8_SB(1, 0), cB0 + kstep, voffB); PG8_STAGE(PG8_SA(1, 0), cA + kstep, va[0]); PG8_STAGE(PG8_SB(1, 1), cB1 + kstep, voffB);
    PG8_WAIT_V(6); PG8_BAR;
    for (;;) {
        const bool has_next = S.next(ui + 1, nxt);
        if constexpr (Sched::GATHER) { unsigned vn[2][2]; if (has_next) S.aoff(nxt, Rp, Cp, vn); else { vn[0][0] = va[0][0]; vn[0][1] = va[0][1]; vn[1][0] = va[1][0]; vn[1][1] = va[1][1]; }
            *vslot = (u32x4){vn[0][0], vn[0][1], vn[1][0], vn[1][1]}; }
        const char* nA = has_next ? nxt.abase : cA; const char* nB0 = has_next ? nxt.b0 : cB0; const char* nB1 = has_next ? nxt.b1 : cB1;
        for (int t = 0; t < nt; t += 2) {
            const bool last = (t == nt - 2);
            const char* a1 = cA + (size_t)(t + 1) * kstep;
            const char* a2 = last ? nA : cA + (size_t)(t + 2) * kstep;
            const char* b20 = last ? nB0 : cB0 + (size_t)(t + 2) * kstep; const char* b21 = last ? nB1 : cB1 + (size_t)(t + 2) * kstep;
            const char* a3 = a2 + kstep; const char* b30 = b20 + kstep; const char* b31 = b21 + kstep;
            PG8_LDB(B0, 0, 0); PG8_LDB(B1, 0, 1); PG8_SCHED; PG8_LDA(At, 0, 0); PG8_STAGE(PG8_SA(1, 1), a1, va[1]);
            PG8_WAIT_V(8); PG8_WAIT_L(0); PG8_BAR; PG8_MMA(0, 0, At, B0); PG8_MMA(0, 1, At, B1); PG8_BAR; PG8_SCHED;
            if constexpr (Sched::GATHER) { if (last) { const u32x4 q = *vslot; va[0][0] = q[0]; va[0][1] = q[1]; va[1][0] = q[2]; va[1][1] = q[3]; } }
            PG8_LDA(At, 0, 1); PG8_STAGE(PG8_SB(0, 0), b20, voffB); PG8_STAGE(PG8_SB(0, 1), b21, voffB); PG8_STAGE(PG8_SA(0, 0), a2, va[0]);
            PG8_WAIT_V(8); PG8_WAIT_L(0); PG8_BAR; PG8_MMA(1, 0, At, B0); PG8_MMA(1, 1, At, B1); PG8_BAR; PG8_SCHED;
            PG8_LDB(B0, 1, 0); PG8_LDB(B1, 1, 1); PG8_SCHED; PG8_LDA(At, 1, 0); PG8_STAGE(PG8_SA(0, 1), a2, va[1]);
            PG8_WAIT_V(8); PG8_WAIT_L(0); PG8_BAR; PG8_MMA(0, 0, At, B0); PG8_MMA(0, 1, At, B1); PG8_BAR; PG8_SCHED;
            PG8_LDA(At, 1, 1); PG8_STAGE(PG8_SB(1, 0), b30, voffB); PG8_STAGE(PG8_SB(1, 1), b31, voffB); PG8_STAGE(PG8_SA(1, 0), a3, va[0]);
            PG8_WAIT_V(8); PG8_WAIT_L(0); PG8_BAR; PG8_MMA(1, 0, At, B0); PG8_MMA(1, 1, At, B1); PG8_BAR; PG8_SCHED;
        }
        if (wr == 0) PG8_BAR;
        E(acc, cur, wr, wc, fr, fq);
        if (!has_next) break;
#pragma unroll
        for (int a = 0; a < 2; ++a)
#pragma unroll
            for (int b = 0; b < 2; ++b)
#pragma unroll
                for (int m = 0; m < 4; ++m)
#pragma unroll
                    for (int n = 0; n < 2; ++n) acc[a][b][m][n] = (f32x4){0.f, 0.f, 0.f, 0.f};
        cur = nxt; cA = nA; cB0 = nB0; cB1 = nB1; ++ui;
        if (wr == 1) PG8_BAR;
    }
    PG8_WAIT_V(0);
    PG8_BAR;
#undef PG8_SA
#undef PG8_SB
#undef PG8_STAGE
#undef PG8_LDA
#undef PG8_LDB
#undef PG8_MMA
#undef PG8_WAIT_V
#undef PG8_WAIT_L
#undef PG8_BAR
#undef PG8_SCHED
}
}
namespace {
constexpr int D = 1024, NB = 8, SEQ = 2048, T = NB * SEQ, PW = 3584, SW = 512, NG = 32, NP = 64, NHC = 16;
constexpr int GW = 512, NHEAD = 8, HD = 64, CHUNK = 128, NCH = SEQ / CHUNK, NE = 32, TOPK = 4, DE = 1024, NMOD = 6;
constexpr int PADROWS = T * TOPK + NE * 256;
constexpr float EPS = 1e-6f;
constexpr int NWAVES = 8, NTHREADS = NWAVES * 64;
constexpr int MODK = 8;

#define GAS __attribute__((address_space(1)))
#define LAS __attribute__((address_space(3)))
typedef unsigned short bf16;
typedef unsigned v4u __attribute__((ext_vector_type(4)));
typedef unsigned v2u __attribute__((ext_vector_type(2)));
typedef int v4i __attribute__((ext_vector_type(4)));
typedef float f32x4 __attribute__((ext_vector_type(4)));
typedef float f32x2 __attribute__((ext_vector_type(2)));
typedef short bf16x8 __attribute__((ext_vector_type(8)));
typedef GAS unsigned gu32;
#define RLX_AGENT __ATOMIC_RELAXED, __HIP_MEMORY_SCOPE_AGENT
#define LDS_WAIT() asm volatile("s_waitcnt lgkmcnt(0)" ::: "memory")
#define VM_WAIT() asm volatile("s_waitcnt vmcnt(0)" ::: "memory")
__device__ __forceinline__ unsigned f2bf(float f) { unsigned u = __builtin_bit_cast(unsigned, f); return (u + 0x7fffu + ((u >> 16) & 1u)) >> 16; }
__device__ __forceinline__ unsigned pk2(float lo, float hi) { return f2bf(lo) | (f2bf(hi) << 16); }
__device__ __forceinline__ float bf2f(unsigned short b) { return __builtin_bit_cast(float, (unsigned)b << 16); }
__device__ __forceinline__ float bflo(unsigned w) { return __builtin_bit_cast(float, w << 16); }
__device__ __forceinline__ float bfhi(unsigned w) { return __builtin_bit_cast(float, w & 0xffff0000u); }
__device__ __forceinline__ float sigm(float x) { return __builtin_amdgcn_rcpf(1.f + __expf(-x)); }
__device__ __forceinline__ float gelu_t(float x) { const float u = 1.5957691216057308f * (x + 0.044715f * x * x * x); return x * sigm(u); }
__device__ __forceinline__ float wave_sum(float v) {
#pragma unroll
    for (int o = 1; o < 64; o <<= 1) v += __shfl_xor(v, o);
    return v;
}

constexpr size_t MiB = 1u << 20;
constexpr size_t WS_CTL = 0, CTL_ZERO_BYTES = 64 * 1024;
constexpr int CW_BAR = 1024;
constexpr size_t WS_MODP = 1 * MiB;
constexpr size_t WS_MOD = 3 * MiB;
constexpr size_t WS_WSM = 4 * MiB;
constexpr size_t WS_CMT = WS_WSM + 512 * 1024;
constexpr size_t WS_RWT = 5 * MiB;
constexpr size_t WS_ROUTE = 6 * MiB;
constexpr size_t WS_SEG = WS_ROUTE + 192 * 1024, WS_SROW = WS_ROUTE + 256 * 1024;
constexpr size_t WS_TOPI = 7 * MiB, WS_TOPW = WS_TOPI + 256 * 1024, WS_POS = WS_TOPW + 256 * 1024;
constexpr size_t WS_KERN = 8 * MiB;
constexpr size_t WS_LAMT = 10 * MiB;
constexpr size_t WS_E = 13 * MiB;
constexpr size_t WS_ME = 16 * MiB;
constexpr size_t WS_WINT = 32 * MiB;
constexpr size_t WS_GLUT = 40 * MiB;
constexpr size_t WS_WAT = 41 * MiB, WS_WBT = 42 * MiB;
constexpr size_t WS_WOT = 43 * MiB;
constexpr size_t WS_W1T = 48 * MiB;
constexpr size_t WS_W2T = 176 * MiB;
constexpr size_t WS_X1 = 240 * MiB;
constexpr size_t WS_H2 = 304 * MiB;
constexpr size_t WS_RX = 336 * MiB;
constexpr size_t WS_RY = 480 * MiB;
constexpr size_t WS_H1 = WS_RY, WS_Z = WS_RY + 32 * MiB, WS_GM = WS_RY + 48 * MiB, WS_OA = WS_RY + 64 * MiB, WS_MB = WS_RY + 80 * MiB, WS_MRG = WS_RY + 112 * MiB;
constexpr size_t WS_END = 624 * MiB;
static_assert((size_t)PADROWS * 1024 * 2 <= 144 * MiB, "act / ys fit their regions");

constexpr int RING_BYTES = 131072;
constexpr int LDSCTL_OFF = RING_BYTES, MISC_OFF = LDSCTL_OFF + 320;
constexpr int LDS_BYTES = 147456;

#define XB_TMO      128
#define XB_XCNT(j)  (256  + 64 * (j))
#define XB_XSUB(j)  (1280 + 64 * (j))
#define XB_XGEN(j)  (2304 + 64 * (j))
#define XB_TOP      3328
#define XB_TOPGEN   3392
#define XCD_BAR_WORDS 3456
#define XB_SPIN_CAP (1u << 18)
__device__ __forceinline__ unsigned xb_ld(unsigned* p)              { return __hip_atomic_load(p, __ATOMIC_RELAXED, __HIP_MEMORY_SCOPE_AGENT); }
__device__ __forceinline__ unsigned xb_add(unsigned* p, unsigned v) { return __hip_atomic_fetch_add(p, v, __ATOMIC_RELAXED, __HIP_MEMORY_SCOPE_AGENT); }
__device__ __forceinline__ unsigned xb_xcc_id() { return (unsigned)__builtin_amdgcn_s_getreg((3 << 11) | 20) & 0xFu; }
#define XB_SPIN(cond, bar) do { unsigned _sp = 0; while (cond) { __builtin_amdgcn_s_sleep(1); \
    if ((++_sp & 255u) == 0u) { if (xb_ld(&(bar)[XB_TMO])) break; if (_sp > XB_SPIN_CAP) { atomicAdd(&(bar)[XB_TMO], 1u); break; } } } } while (0)
struct XcdBarrier { unsigned* bar; unsigned x; volatile LAS unsigned* st; };
__device__ __forceinline__ XcdBarrier xcd_barrier_post(unsigned* bar, volatile LAS unsigned* st) {
    XcdBarrier b; b.bar = bar; b.x = xb_xcc_id(); b.st = st;
    if (threadIdx.x == 0) (void)xb_add(&bar[XB_XCNT(b.x)], 1u);
    return b;
}
__device__ __forceinline__ void xcd_barrier_complete(unsigned* bar, unsigned x, unsigned& nloc, unsigned& nx) {
    const unsigned G = gridDim.x * gridDim.y * gridDim.z;
    unsigned sum, cnt, mine, sp = 0u;
    for (;;) {
        sum = 0u; cnt = 0u; mine = 0u;
#pragma unroll
        for (unsigned j = 0; j < 16; ++j) { const unsigned c = xb_ld(&bar[XB_XCNT(j)]); sum += c; cnt += (c > 0u) ? 1u : 0u; mine = (j == x) ? c : mine; }
        if (sum == G) break;
        __builtin_amdgcn_s_sleep(1);
        if ((++sp & 255u) == 0u) { if (xb_ld(&bar[XB_TMO])) break; if (sp > XB_SPIN_CAP) { atomicAdd(&bar[XB_TMO], 1u); break; } }
    }
    nloc = mine > 0u ? mine : 1u; nx = cnt > 0u ? cnt : 1u;
}
__device__ __forceinline__ void xcd_barrier(const XcdBarrier& b) {
    asm volatile("s_waitcnt vmcnt(0)" ::: "memory");
    __syncthreads();
    if (threadIdx.x == 0) {
        unsigned* bar = b.bar;
        __builtin_amdgcn_s_waitcnt(0);
        unsigned nloc = b.st[0], nx = b.st[1];
        if (nloc == 0u) { xcd_barrier_complete(bar, b.x, nloc, nx); b.st[0] = nloc; b.st[1] = nx; }
        const unsigned old = xb_add(&bar[XB_XSUB(b.x)], 1u);
        const unsigned gen = old / nloc;
        if (old + 1u == (gen + 1u) * nloc) {
            __builtin_amdgcn_fence(__ATOMIC_RELEASE, "agent");
            asm volatile("s_waitcnt vmcnt(0)" ::: "memory");
            const unsigned og = xb_add(&bar[XB_TOP], 1u);
            const unsigned tg = og / nx;
            if (og + 1u == (tg + 1u) * nx) xb_add(&bar[XB_TOPGEN], 1u);
            else XB_SPIN(xb_ld(&bar[XB_TOPGEN]) == tg, bar);
            __builtin_amdgcn_fence(__ATOMIC_ACQUIRE, "agent");
            xb_add(&bar[XB_XGEN(b.x)], 1u);
            asm volatile("s_waitcnt vmcnt(0)" ::: "memory");
        } else {
            XB_SPIN(xb_ld(&bar[XB_XGEN(b.x)]) == gen, bar);
            __builtin_amdgcn_fence(__ATOMIC_ACQUIRE, "agent");
            asm volatile("s_waitcnt vmcnt(0)" ::: "memory");
        }
    }
    __syncthreads();
}

struct Args { const float* in[31]; float* out; unsigned char* ws; int ph_lo, ph_hi, rep, pad; };
struct Frame {
    LAS unsigned char* lds;
    int wave, vcu, G;
};
struct DenseOrder {
    const char* A; const char* Bt; int K, nM, nN, nwg, G, c;
    __device__ __forceinline__ void init(const void* A_, const void* Bt_, int M, int N, int K_, int G_, int c_) { A = (const char*)A_; Bt = (const char*)Bt_; K = K_; nM = M / 256; nN = N / 256; nwg = nM * nN; G = G_; c = c_; }
    __device__ __forceinline__ bool next(int i, pg8::Unit& u) const {
        const long L = (long)i * G + c; if (L >= nwg) return false;
        int wgid = (int)L; { const int q = nwg / 8, r = nwg % 8, xcd = wgid % 8, off = wgid / 8; wgid = (xcd < r ? xcd * (q + 1) : r * (q + 1) + (xcd - r) * q) + off; }
        const int nig = 8 * nN, gid = wgid / nig, fm = gid * 8, gsz = (nM - fm) < 8 ? (nM - fm) : 8;
        u.pm = fm + ((wgid % nig) % gsz); u.pn = (wgid % nig) / gsz; u.aux = 0;
        u.abase = A + (size_t)u.pm * 256 * K * 2; u.b0 = Bt + (size_t)u.pn * 256 * K * 2; u.b1 = u.b0 + (size_t)128 * K * 2; return true;
    }
    static constexpr bool GATHER = false;
    __device__ __forceinline__ void aoff(const pg8::Unit&, const int (&R)[2], const int (&C)[2], unsigned (&va)[2][2]) const {
#pragma unroll
        for (int h = 0; h < 2; ++h)
#pragma unroll
            for (int i = 0; i < 2; ++i) va[h][i] = (unsigned)((h * 128 + R[i]) * K + C[i]) * 2u;
    }
};

__device__ __forceinline__ void p0_transpose_item(const float* W, int K, int N, bf16* WT, LAS float* scr, int item, int lane) {
    const int nblk = N / 32, kb = item / nblk, nb = item % nblk, k0 = 64 * kb, n0 = 32 * nb;
#pragma unroll 8
    for (int i = 0; i < 32; ++i) { const int kk = 2 * i + (lane >> 5); scr[kk * 33 + (lane & 31)] = W[(size_t)(k0 + kk) * N + n0 + (lane & 31)]; }
    LDS_WAIT(); asm volatile("" ::: "memory");
    const int c = lane & 7;
#pragma unroll
    for (int j = 0; j < 4; ++j) { const int n = (lane >> 3) + 8 * j; const LAS float* s = scr + (8 * c) * 33 + n;
        v4u o; o.x = pk2(s[0 * 33], s[1 * 33]); o.y = pk2(s[2 * 33], s[3 * 33]); o.z = pk2(s[4 * 33], s[5 * 33]); o.w = pk2(s[6 * 33], s[7 * 33]);
        *(GAS v4u*)(WT + (size_t)(n0 + n) * K + k0 + 8 * c) = o; }
    LDS_WAIT(); asm volatile("" ::: "memory");
}
__device__ __forceinline__ void p0_s5_item(const Args& A, unsigned char* ws, LAS float* scr, int item, int lane) {
    const int g = item / 129, tau = item % 129, p = lane;
    const float* a_re = A.in[6]; const float* a_im = A.in[7]; const float* log_dt = A.in[8]; const float* b_re = A.in[9]; const float* b_im = A.in[10]; const float* c_re = A.in[11]; const float* c_im = A.in[12];
    if (tau < 128) {
#pragma unroll
        for (int i = 0; i < 4; ++i) { *(LAS f32x4*)(scr + 2048 + (lane + 64 * i) * 4) = ((const GAS f32x4*)(c_re + (size_t)g * NHC * NP))[lane + 64 * i]; *(LAS f32x4*)(scr + 3072 + (lane + 64 * i) * 4) = ((const GAS f32x4*)(c_im + (size_t)g * NHC * NP))[lane + 64 * i]; }
    }
    const double dt = exp((double)log_dt[g]);
    const double lr = a_re[g * NP + p], li = a_im[g * NP + p];
    const double mg = exp(lr * dt * (double)tau), an = li * dt * (double)tau;
    const float ltr = (float)(mg * cos(an)), lti = (float)(mg * sin(an));
    ((GAS f32x2*)(ws + WS_LAMT))[(size_t)(g * 129 + tau) * NP + p] = (f32x2){ltr, lti};
    if (tau == 128) return;
    const double m1 = exp(lr * dt), lbr = m1 * cos(li * dt), lbi = m1 * sin(li * dt);
    const double nr = lbr - 1.0, ni = lbi, den = lr * lr + li * li;
    const float cfr = (float)((nr * lr + ni * li) / den), cfi = (float)((ni * lr - nr * li) / den);
    const float wr_ = ltr * cfr - lti * cfi, wi_ = ltr * cfi + lti * cfr;
    const f32x4* brp = (const f32x4*)(b_re + (size_t)(g * NP + p) * NHC); const f32x4* bip = (const f32x4*)(b_im + (size_t)(g * NP + p) * NHC);
    unsigned mre[8], mim[8];
#pragma unroll
    for (int q = 0; q < 4; ++q) { const f32x4 br = brp[q], bi = bip[q]; float vr[4], vi[4];
#pragma unroll
        for (int j = 0; j < 4; ++j) { vr[j] = wr_ * br[j] - wi_ * bi[j]; vi[j] = wr_ * bi[j] + wi_ * br[j]; scr[(p * 16 + q * 4 + j) * 2] = vr[j]; scr[(p * 16 + q * 4 + j) * 2 + 1] = vi[j]; }
        mre[2 * q] = pk2(vr[0], vr[1]); mre[2 * q + 1] = pk2(vr[2], vr[3]); mim[2 * q] = pk2(vi[0], vi[1]); mim[2 * q + 1] = pk2(vi[2], vi[3]); }
    { GAS v4u* o = (GAS v4u*)((bf16*)(ws + WS_ME) + ((size_t)(g * 128 + 2 * p) * 2048 + (127 - tau) * 16));
      o[0] = (v4u){mre[0], mre[1], mre[2], mre[3]}; o[1] = (v4u){mre[4], mre[5], mre[6], mre[7]};
      GAS v4u* o2 = (GAS v4u*)((bf16*)(ws + WS_ME) + ((size_t)(g * 128 + 2 * p + 1) * 2048 + (127 - tau) * 16));
      o2[0] = (v4u){mim[0], mim[1], mim[2], mim[3]}; o2[1] = (v4u){mim[4], mim[5], mim[6], mim[7]}; }
    LDS_WAIT(); asm volatile("" ::: "memory");
    const int ho = lane >> 2, hi0 = 4 * (lane & 3);
    const LAS float* crp = scr + 2048 + ho * NP; const LAS float* cip = scr + 3072 + ho * NP;
    float kk[4] = {0.f, 0.f, 0.f, 0.f};
#pragma unroll 8
    for (int pp = 0; pp < NP; ++pp) { const float cr = crp[pp], ci = cip[pp];
#pragma unroll
        for (int j = 0; j < 4; ++j) { const f32x2 w = *(const LAS f32x2*)(scr + (pp * 16 + hi0 + j) * 2); kk[j] += cr * w.x - ci * w.y; } }
    *(GAS v2u*)((bf16*)(ws + WS_KERN) + ((size_t)(g * 128 + tau) * 256 + ho * 16 + hi0)) = (v2u){pk2(kk[0], kk[1]), pk2(kk[2], kk[3])};
    LDS_WAIT(); asm volatile("" ::: "memory");
}
__device__ __forceinline__ void p0_mod_block_item(const Args& A, unsigned char* ws, LAS unsigned char* lds, int wave, int item) {
    const float* c = A.in[1]; const float* ada_w = A.in[2]; const float* ada_b = A.in[3];
    const int lane = (int)threadIdx.x & 63, j = item * 64 + lane;
    LAS float* scr = (LAS float*)(lds + wave * 16384);
    for (int i = lane; i < 8 * 128; i += 64) { const int b = i >> 7, k = i & 127; const float cv = c[b * D + wave * 128 + k]; scr[k * 8 + b] = cv / (1.f + __expf(-cv)); }
    LDS_WAIT(); asm volatile("" ::: "memory");
    float acc[8] = {0.f, 0.f, 0.f, 0.f, 0.f, 0.f, 0.f, 0.f};
    const float* wp = ada_w + (size_t)(wave * 128) * (NMOD * D) + j;
#pragma unroll 1
    for (int k0 = 0; k0 < 128; k0 += 16) { float wv[16];
#pragma unroll
        for (int q = 0; q < 16; ++q) wv[q] = wp[(size_t)(k0 + q) * (NMOD * D)];
#pragma unroll
        for (int q = 0; q < 16; ++q) { const f32x4 s0 = *(const LAS f32x4*)(scr + (k0 + q) * 8), s1 = *(const LAS f32x4*)(scr + (k0 + q) * 8 + 4);
            acc[0] += s0[0] * wv[q]; acc[1] += s0[1] * wv[q]; acc[2] += s0[2] * wv[q]; acc[3] += s0[3] * wv[q]; acc[4] += s1[0] * wv[q]; acc[5] += s1[1] * wv[q]; acc[6] += s1[2] * wv[q]; acc[7] += s1[3] * wv[q]; } }
    LDS_WAIT(); __syncthreads();
    LAS float* red = (LAS float*)lds;
#pragma unroll
    for (int b = 0; b < 8; ++b) red[(wave * 8 + b) * 64 + lane] = acc[b];
    LDS_WAIT(); __syncthreads();
    { float v = ada_b[j];
#pragma unroll
      for (int w2 = 0; w2 < 8; ++w2) v += red[(w2 * 8 + wave) * 64 + lane];
      ((float*)(ws + WS_MOD))[wave * (NMOD * D) + j] = v; }
    LDS_WAIT(); __syncthreads();
}
__device__ __forceinline__ void p0_prologue(const Args& A, const Frame& F) {
    unsigned char* ws = A.ws;
    LAS float* scr = (LAS float*)(F.lds + F.wave * 16384);
    const int gw = F.vcu * NWAVES + F.wave, NGW = F.G * NWAVES;
    constexpr int I_S5 = NG * 129, I_MOD = NMOD * D / 64;
    constexpr int I_WIN = (D / 64) * (PW / 32), I_GLU = (SW / 64) * (SW / 32), I_BR = (SW / 64) * (D / 32), I_WO = (D / 64) * (D / 32), I_M1 = (D / 64) * (2 * DE / 32), I_M2 = (DE / 64) * (D / 32);
    constexpr int NITEMS = I_S5 + I_WIN + I_GLU + 2 * I_BR + I_WO + NE * I_M1 + NE * I_M2;
    for (int it = F.vcu; it < I_MOD; it += F.G) p0_mod_block_item(A, ws, F.lds, F.wave, it);
    for (int it = gw; it < NITEMS; it += NGW) {
        int r = it;
        if (r < I_S5) { p0_s5_item(A, ws, scr, r, ((int)threadIdx.x & 63)); continue; } r -= I_S5;
        if (r < I_WIN) { p0_transpose_item(A.in[5], D, PW, (bf16*)(ws + WS_WINT), scr, r, ((int)threadIdx.x & 63)); continue; } r -= I_WIN;
        if (r < I_GLU) { p0_transpose_item(A.in[14], SW, SW, (bf16*)(ws + WS_GLUT), scr, r, ((int)threadIdx.x & 63)); continue; } r -= I_GLU;
        if (r < I_BR) { p0_transpose_item(A.in[16], SW, D, (bf16*)(ws + WS_WAT), scr, r, ((int)threadIdx.x & 63)); continue; } r -= I_BR;
        if (r < I_BR) { p0_transpose_item(A.in[21], SW, D, (bf16*)(ws + WS_WBT), scr, r, ((int)threadIdx.x & 63)); continue; } r -= I_BR;
        if (r < I_WO) { p0_transpose_item(A.in[22], D, D, (bf16*)(ws + WS_WOT), scr, r, ((int)threadIdx.x & 63)); continue; } r -= I_WO;
        if (r < NE * I_M1) { const int e = r / I_M1; p0_transpose_item(A.in[26] + (size_t)e * D * 2 * DE, D, 2 * DE, (bf16*)(ws + WS_W1T) + (size_t)e * 2 * DE * D, scr, r % I_M1, ((int)threadIdx.x & 63)); continue; } r -= NE * I_M1;
        { const int e = r / I_M2; p0_transpose_item(A.in[28] + (size_t)e * DE * D, DE, D, (bf16*)(ws + WS_W2T) + (size_t)e * D * DE, scr, r % I_M2, ((int)threadIdx.x & 63)); }
    }
    const int gt = F.vcu * NTHREADS + ((int)threadIdx.x), NGT = F.G * NTHREADS;
    for (int i = gt; i < NG * NHC * 128; i += NGT) { const int k = i & 127, ho = (i >> 7) & 15, g = i >> 11, p = k >> 1;
        const float v = (k & 1) ? -A.in[12][(size_t)(g * NHC + ho) * NP + p] : A.in[11][(size_t)(g * NHC + ho) * NP + p]; ((bf16*)(ws + WS_CMT))[i] = (bf16)f2bf(v); }
    for (int i = gt; i < NHEAD * CHUNK * CHUNK; i += NGT) { const int s = i & 127, t = (i >> 7) & 127; ((bf16*)(ws + WS_WSM))[i] = (s <= t) ? (bf16)f2bf(A.in[19][i]) : (bf16)0; }
    for (int i = gt; i < D * NE; i += NGT) { const int e = i & 31, k = i >> 5; const float v = A.in[24][i]; const unsigned hi = f2bf(v); const float lo = v - bf2f((unsigned short)hi);
        ((bf16*)(ws + WS_RWT))[e * D + k] = (bf16)hi; ((bf16*)(ws + WS_RWT))[NE * D + e * D + k] = (bf16)f2bf(lo); }
}

__device__ __forceinline__ void norm_mod_row_bf16(const float* xrow, const float* g, const float* shift, const float* scale, bf16* orow, int lane) {
    const GAS f32x4* xr = (const GAS f32x4*)xrow + lane;
    f32x4 v[4]; float s = 0.f;
#pragma unroll
    for (int j = 0; j < 4; ++j) { v[j] = xr[64 * j]; s += (v[j].x * v[j].x + v[j].y * v[j].y) + (v[j].z * v[j].z + v[j].w * v[j].w); }
    const float r = rsqrtf(wave_sum(s) * (1.f / D) + EPS);
    GAS v2u* o8 = (GAS v2u*)orow + lane;
#pragma unroll
    for (int j = 0; j < 4; ++j) { const f32x4 gg = ((const GAS f32x4*)g)[lane + 64 * j], sh = ((const GAS f32x4*)shift)[lane + 64 * j], sc = ((const GAS f32x4*)scale)[lane + 64 * j];
        const f32x4 o = v[j] * r * gg * (sc + 1.f) + sh; o8[64 * j] = (v2u){pk2(o.x, o.y), pk2(o.z, o.w)}; }
}
__device__ __forceinline__ void p1_h1(const Args& A, const Frame& F) {
    const int gw = F.vcu * NWAVES + F.wave, NGW = F.G * NWAVES;
    const float* mod = (const float*)(A.ws + WS_MOD);
    for (int m = gw; m < T; m += NGW) { const int b = m / SEQ;
        norm_mod_row_bf16(A.in[0] + (size_t)m * D, A.in[4], mod + b * (NMOD * D), mod + b * (NMOD * D) + D, (bf16*)(A.ws + WS_H1) + (size_t)m * D, ((int)threadIdx.x & 63)); }
}

struct EpiProj {
    static constexpr bool PERM = true;
    bf16* O;
    __device__ __forceinline__ void operator()(const pg8::f32x4 (&acc)[2][2][4][2], const pg8::Unit& u, int wr, int wc, int fr, int fq) const {
        const int row0 = u.pm * 256 + wr * 64 + fr, col0 = u.pn * 256 + wc * 32 + 8 * fq;
        const int mode = u.pn < 2 ? 0 : (u.pn < 6 ? 1 : 2);
#pragma unroll
        for (int ai = 0; ai < 2; ++ai)
#pragma unroll
            for (int m = 0; m < 4; ++m) { bf16* rowp = O + (size_t)(row0 + ai * 128 + m * 16) * PW + col0;
#pragma unroll
                for (int bj = 0; bj < 2; ++bj) { float v[8];
#pragma unroll
                    for (int j = 0; j < 4; ++j) { v[j] = acc[ai][bj][m][0][j]; v[4 + j] = acc[ai][bj][m][1][j]; }
                    if (mode == 1) {
#pragma unroll
                        for (int j = 0; j < 8; ++j) v[j] = gelu_t(v[j]); }
                    else if (mode == 2) {
#pragma unroll
                        for (int j = 0; j < 8; ++j) v[j] = sigm(v[j]); }
                    *(v4u*)(rowp + bj * 128) = (v4u){pk2(v[0], v[1]), pk2(v[2], v[3]), pk2(v[4], v[5]), pk2(v[6], v[7])}; } }
    }
};
__device__ __forceinline__ void p2_proj(const Args& A, const Frame& F) {
    DenseOrder S; S.init(A.ws + WS_H1, A.ws + WS_WINT, T, PW, D, F.G, (int)blockIdx.x);
    EpiProj E{(bf16*)(A.ws + WS_RX)};
    pg8::gemm_phase<EpiProj, DenseOrder>(F.lds, D, S, E);
}
__device__ __forceinline__ void p3_epass_unit(const Args& A, const Frame& F, int unit) {
    const int b = unit >> 5, g = unit & 31, lane = ((int)threadIdx.x & 63), m = lane & 15, kq = lane >> 4;
    const bf16* PA = (const bf16*)(A.ws + WS_RX);
    const bf16* ua = PA + ((size_t)(b * SEQ + m * CHUNK) * PW + g * NHC + 8 * (kq & 1));
    const bf16* mb = (const bf16*)(A.ws + WS_ME) + ((size_t)(g * 128 + F.wave * 16 + m) * 2048 + 8 * kq);
    f32x4 acc = {0.f, 0.f, 0.f, 0.f};
#pragma unroll 1
    for (int k0 = 0; k0 < 64; k0 += 8) {
        bf16x8 af[8], bfr[8];
#pragma unroll
        for (int j = 0; j < 8; ++j) { const int kk = k0 + j; af[j] = *(const GAS bf16x8*)(ua + (size_t)(2 * kk + (kq >> 1)) * PW); bfr[j] = *(const GAS bf16x8*)(mb + 32 * kk); }
#pragma unroll
        for (int j = 0; j < 8; ++j) acc = __builtin_amdgcn_mfma_f32_16x16x32_bf16(bfr[j], af[j], acc, 0, 0, 0);
    }
    *(GAS f32x4*)((float*)(A.ws + WS_E) + ((size_t)((b * NCH + m) * NG + g) * 128 + F.wave * 16 + 4 * kq)) = acc;
}

constexpr int VNT_STRIDE = 272;
__device__ __forceinline__ void p3_gmlp_unit(const Args& A, const Frame& F, int unit) {
    const int chunk = unit >> 1, hh = unit & 1, lane = ((int)threadIdx.x & 63), w = F.wave;
    const bf16* PA = (const bf16*)(A.ws + WS_RX);
    const float* lng = A.in[17]; const float* lnb = A.in[18];
    const f32x4 g0 = *(const GAS f32x4*)(lng + 8 * lane), g1 = *(const GAS f32x4*)(lng + 8 * lane + 4), b0 = *(const GAS f32x4*)(lnb + 8 * lane), b1 = *(const GAS f32x4*)(lnb + 8 * lane + 4);
#pragma unroll 4
    for (int i = 0; i < 16; ++i) {
        const int s = 16 * w + i;
        const v4u raw = *(const GAS v4u*)(PA + (size_t)(chunk * CHUNK + s) * PW + 2 * GW + 8 * lane);
        float v[8] = {bflo(raw.x), bfhi(raw.x), bflo(raw.y), bfhi(raw.y), bflo(raw.z), bfhi(raw.z), bflo(raw.w), bfhi(raw.w)};
        float sm = 0.f;
#pragma unroll
        for (int j = 0; j < 8; ++j) sm += v[j];
        const float mu = wave_sum(sm) * (1.f / GW);
        float sq = 0.f;
#pragma unroll
        for (int j = 0; j < 8; ++j) { v[j] -= mu; sq += v[j] * v[j]; }
        const float r = rsqrtf(wave_sum(sq) * (1.f / GW) + EPS);
        if ((lane >> 5) == hh) {
            LAS unsigned char* dst = F.lds + (8 * (lane & 31)) * VNT_STRIDE + 2 * s;
#pragma unroll
            for (int j = 0; j < 8; ++j) { const float o = v[j] * r * (j < 4 ? g0[j & 3] : g1[j & 3]) + (j < 4 ? b0[j & 3] : b1[j & 3]); *(LAS unsigned short*)(dst + j * VNT_STRIDE) = (unsigned short)f2bf(o); }
        }
    }
    LDS_WAIT(); __syncthreads();
    const int hl = w >> 1, th = w & 1, h = 4 * hh + hl, fr = lane & 15, kq = lane >> 4;
    const bf16* wsm = (const bf16*)(A.ws + WS_WSM) + (size_t)h * CHUNK * CHUNK;
    f32x4 acc[4][4];
#pragma unroll
    for (int cb = 0; cb < 4; ++cb)
#pragma unroll
        for (int tb = 0; tb < 4; ++tb) acc[cb][tb] = (f32x4){0.f, 0.f, 0.f, 0.f};
    const int kmax = th ? 4 : 2;
    for (int kk = 0; kk < kmax; ++kk) {
        bf16x8 vf[4], wf[4];
#pragma unroll
        for (int cb = 0; cb < 4; ++cb) vf[cb] = *(const LAS bf16x8*)(F.lds + (64 * hl + 16 * cb + fr) * VNT_STRIDE + (32 * kk + 8 * kq) * 2);
#pragma unroll
        for (int tb = 0; tb < 4; ++tb) wf[tb] = *(const GAS bf16x8*)(wsm + (size_t)(64 * th + 16 * tb + fr) * CHUNK + 32 * kk + 8 * kq);
#pragma unroll
        for (int cb = 0; cb < 4; ++cb)
#pragma unroll
            for (int tb = 0; tb < 4; ++tb) acc[cb][tb] = __builtin_amdgcn_mfma_f32_16x16x32_bf16(vf[cb], wf[tb], acc[cb][tb], 0, 0, 0);
    }
    const float* bs = A.in[20] + h * CHUNK;
    bf16* GM = (bf16*)(A.ws + WS_GM);
#pragma unroll
    for (int tb = 0; tb < 4; ++tb) { const int t = 64 * th + 16 * tb + fr; const float bias = bs[t]; const size_t row = (size_t)(chunk * CHUNK + t);
#pragma unroll
        for (int cb = 0; cb < 4; ++cb) { const int cg = 256 * hh + 64 * hl + 16 * cb + 4 * kq;
            const v2u gu = *(const GAS v2u*)(PA + row * PW + GW + cg);
            const float o0 = bflo(gu.x) * (acc[cb][tb][0] + bias), o1 = bfhi(gu.x) * (acc[cb][tb][1] + bias), o2 = bflo(gu.y) * (acc[cb][tb][2] + bias), o3 = bfhi(gu.y) * (acc[cb][tb][3] + bias);
            *(GAS v2u*)(GM + row * GW + cg) = (v2u){pk2(o0, o1), pk2(o2, o3)}; } }
    __syncthreads();
}
__device__ __forceinline__ void p3_phase(const Args& A, const Frame& F) {
    for (int u = F.vcu; u < NB * NG + 2 * (T / CHUNK); u += F.G) { if (u < NB * NG) p3_epass_unit(A, F, u); else p3_gmlp_unit(A, F, u - NB * NG); }
}

constexpr int Y_KERN = 0, Y_UT = 65536, Y_UTW = 4608, Y_CMT = Y_UT + 8 * Y_UTW, Y_CMT_STRIDE = 272, Y_XS = Y_CMT + 16 * Y_CMT_STRIDE, Y_END = Y_XS + 8 * 512;
static_assert(Y_END <= RING_BYTES, "Y-pass LDS map");
__device__ __forceinline__ void p4_ypass_unit(const Args& A, const Frame& F, int unit) {
    int lane = ((int)threadIdx.x & 63), tid = ((int)threadIdx.x); asm volatile("" : "+v"(lane), "+v"(tid));
    const int g = unit >> 4, o = unit & 15, w = F.wave, gc = 8 * o + w, b = gc >> 4, c = gc & 15;
    int fr = lane & 15, kq = lane >> 4;
    const bf16* PA = (const bf16*)(A.ws + WS_RX);
    LAS unsigned char* lds = F.lds;
    { const GAS v4u* src = (const GAS v4u*)(A.ws + WS_KERN + (size_t)g * 65536);
#pragma unroll
      for (int i = 0; i < 8; ++i) *(LAS v4u*)(lds + Y_KERN + (tid + 512 * i) * 16) = src[tid + 512 * i]; }
    if (tid < 256) { const int ho = tid >> 4, ch = tid & 15; *(LAS v4u*)(lds + Y_CMT + ho * Y_CMT_STRIDE + ch * 16) = *(const GAS v4u*)(A.ws + WS_CMT + (size_t)(g * NHC + ho) * 256 + ch * 16); }
    LAS unsigned char* ut = lds + Y_UT + w * Y_UTW;
#pragma unroll
    for (int i = 0; i < 4; ++i) { const int id = lane + 64 * i, s = id >> 1, half = id & 1;
        *(LAS v4u*)(ut + half * 2304 + (16 + s) * 16) = *(const GAS v4u*)(PA + (size_t)(gc * CHUNK + s) * PW + g * NHC + 8 * half); }
    if (lane < 32) *(LAS v4u*)(ut + (lane >> 4) * 2304 + (lane & 15) * 16) = (v4u){0u, 0u, 0u, 0u};
    { const f32x2 l128 = ((const GAS f32x2*)(A.ws + WS_LAMT))[(size_t)(g * 129 + 128) * NP + lane];
      const GAS f32x2* ep = (const GAS f32x2*)((const float*)(A.ws + WS_E) + ((size_t)(b * NCH) * NG + g) * 128) + lane;
      float xr = 0.f, xi = 0.f;
      for (int cp = 0; cp < c; ++cp) { const f32x2 e = ep[(size_t)cp * NG * 64]; const float nr = l128.x * xr - l128.y * xi + e.x, ni = l128.x * xi + l128.y * xr + e.y; xr = nr; xi = ni; }
      *(LAS f32x2*)(lds + Y_XS + w * 512 + lane * 8) = (f32x2){xr, xi}; }
    LDS_WAIT(); __syncthreads();
    asm volatile("" : "+v"(lane)); fr = lane & 15; kq = lane >> 4;
    f32x4 acc[8];
#pragma unroll
    for (int i = 0; i < 8; ++i) acc[i] = (f32x4){0.f, 0.f, 0.f, 0.f};
    const LAS unsigned char* kbase = lds + Y_KERN + (kq >> 1) * 512 + fr * 32 + (kq & 1) * 16;
    const LAS unsigned char* ubase = ut + (kq & 1) * 2304 + (16 + fr - (kq >> 1)) * 16;
#pragma unroll 1
    for (int qb = 0; qb < 8; ++qb) {
#pragma unroll 1
        for (int ql = 0; ql < 8; ++ql) { const int q = 8 * qb + ql;
            const bf16x8 kf = *(const LAS bf16x8*)(kbase + q * 1024);
#pragma unroll
            for (int i = 0; i < 8; ++i) if (i >= qb) { const bf16x8 uf = *(const LAS bf16x8*)(ubase + (16 * i - 2 * q) * 16); acc[i] = __builtin_amdgcn_mfma_f32_16x16x32_bf16(kf, uf, acc[i], 0, 0, 0); }
        }
    }
    asm volatile("" : "+v"(lane)); fr = lane & 15; kq = lane >> 4;
    {
        bf16x8 cf[4]; float z[4][8], l16[4][8];
#pragma unroll
        for (int kk = 0; kk < 4; ++kk) {
            cf[kk] = *(const LAS bf16x8*)(lds + Y_CMT + fr * Y_CMT_STRIDE + (32 * kk + 8 * kq) * 2);
            const f32x4 x0 = *(const LAS f32x4*)(lds + Y_XS + w * 512 + (16 * kk + 4 * kq) * 8), x1 = *(const LAS f32x4*)(lds + Y_XS + w * 512 + (16 * kk + 4 * kq) * 8 + 16);
            const GAS f32x4* lp = (const GAS f32x4*)((const float*)(A.ws + WS_LAMT) + ((size_t)(g * 129 + fr + 1) * NP + 16 * kk + 4 * kq) * 2);
            const GAS f32x4* lq = (const GAS f32x4*)((const float*)(A.ws + WS_LAMT) + ((size_t)(g * 129 + 16) * NP + 16 * kk + 4 * kq) * 2);
            const f32x4 l0 = lp[0], l1 = lp[1], q0 = lq[0], q1 = lq[1];
            z[kk][0] = l0[0] * x0[0] - l0[1] * x0[1]; z[kk][1] = l0[0] * x0[1] + l0[1] * x0[0]; z[kk][2] = l0[2] * x0[2] - l0[3] * x0[3]; z[kk][3] = l0[2] * x0[3] + l0[3] * x0[2];
            z[kk][4] = l1[0] * x1[0] - l1[1] * x1[1]; z[kk][5] = l1[0] * x1[1] + l1[1] * x1[0]; z[kk][6] = l1[2] * x1[2] - l1[3] * x1[3]; z[kk][7] = l1[2] * x1[3] + l1[3] * x1[2];
#pragma unroll
            for (int j = 0; j < 4; ++j) { l16[kk][j] = q0[j]; l16[kk][4 + j] = q1[j]; }
        }
#pragma unroll
        for (int i = 0; i < 8; ++i) {
#pragma unroll
            for (int kk = 0; kk < 4; ++kk) {
                const v4u zp = (v4u){pk2(z[kk][0], z[kk][1]), pk2(z[kk][2], z[kk][3]), pk2(z[kk][4], z[kk][5]), pk2(z[kk][6], z[kk][7])};
                acc[i] = __builtin_amdgcn_mfma_f32_16x16x32_bf16(cf[kk], __builtin_bit_cast(bf16x8, zp), acc[i], 0, 0, 0);
                if (i < 7) {
#pragma unroll
                    for (int j = 0; j < 4; ++j) { const float zr = z[kk][2 * j], zi = z[kk][2 * j + 1], lr = l16[kk][2 * j], li = l16[kk][2 * j + 1]; z[kk][2 * j] = lr * zr - li * zi; z[kk][2 * j + 1] = lr * zi + li * zr; }
                }
            }
        }
    }
    asm volatile("" : "+v"(lane)); fr = lane & 15; kq = lane >> 4;
    const f32x4 dsk = *(const GAS f32x4*)(A.in[13] + g * NHC + 4 * kq);
    bf16* Z = (bf16*)(A.ws + WS_Z);
#pragma unroll
    for (int i = 0; i < 8; ++i) { const int t = 16 * i + fr;
        const v2u uu = *(const LAS v2u*)(ut + (kq >> 1) * 2304 + (16 + t) * 16 + (kq & 1) * 8);
        const float y0 = acc[i][0] + dsk[0] * bflo(uu.x), y1 = acc[i][1] + dsk[1] * bfhi(uu.x), y2 = acc[i][2] + dsk[2] * bflo(uu.y), y3 = acc[i][3] + dsk[3] * bfhi(uu.y);
        *(GAS v2u*)(Z + (size_t)(gc * CHUNK + t) * SW + g * NHC + 4 * kq) = (v2u){pk2(gelu_t(y0), gelu_t(y1)), pk2(gelu_t(y2), gelu_t(y3))}; }
    __syncthreads();
}
__device__ __forceinline__ void p4_phase(const Args& A, const Frame& F) {
    for (int u = F.vcu; u < NG * (T / CHUNK / 8); u += F.G) p4_ypass_unit(A, F, u);
}
struct P5Order {
    const char *GM, *WBT, *Z, *GLUT; int G, c;
    __device__ __forceinline__ bool next(int i, pg8::Unit& u) const {
        const long L = (long)i * G + c; if (L >= 384) return false;
        const bool glu = L >= 256; int wgid = glu ? (int)L - 256 : (int)L; const int nN = glu ? 2 : 4, nwg = 64 * nN;
        { const int q = nwg / 8, xcd = wgid % 8, off = wgid / 8; wgid = xcd * q + off; }
        const int nig = 8 * nN, gid = wgid / nig, fm = gid * 8;
        u.pm = fm + ((wgid % nig) % 8); u.pn = (wgid % nig) / 8; u.aux = glu ? 1 : 0;
        u.abase = (glu ? Z : GM) + (size_t)u.pm * 256 * SW * 2; u.b0 = (glu ? GLUT : WBT) + (size_t)u.pn * 256 * SW * 2; u.b1 = u.b0 + (size_t)128 * SW * 2; return true;
    }
    static constexpr bool GATHER = false;
    __device__ __forceinline__ void aoff(const pg8::Unit&, const int (&R)[2], const int (&C)[2], unsigned (&va)[2][2]) const {
#pragma unroll
        for (int h = 0; h < 2; ++h)
#pragma unroll
            for (int i = 0; i < 2; ++i) va[h][i] = (unsigned)((h * 128 + R[i]) * SW + C[i]) * 2u;
    }
};
struct EpiP5 {
    static constexpr bool PERM = true;
    const bf16* PA; const bf16* Z; const float* glu_b; bf16* MB; bf16* OA;
    __device__ __forceinline__ void operator()(const pg8::f32x4 (&acc)[2][2][4][2], const pg8::Unit& u, int wr, int wc, int fr, int fq) const {
        const int row0 = u.pm * 256 + wr * 64 + fr, col0 = u.pn * 256 + wc * 32 + 8 * fq;
        if (u.aux == 0) {
#pragma unroll
            for (int ai = 0; ai < 2; ++ai)
#pragma unroll
                for (int m = 0; m < 4; ++m) { const size_t row = (size_t)(row0 + ai * 128 + m * 16);
#pragma unroll
                    for (int bj = 0; bj < 2; ++bj) { const int col = col0 + bj * 128;
                        const v4u s = *(const GAS v4u*)(PA + row * PW + (SW + 2 * GW + D) + col);
                        const pg8::f32x4 a0 = acc[ai][bj][m][0], a1 = acc[ai][bj][m][1];
                        *(GAS v4u*)(MB + row * D + col) = (v4u){pk2(bflo(s.x) * a0[0], bfhi(s.x) * a0[1]), pk2(bflo(s.y) * a0[2], bfhi(s.y) * a0[3]), pk2(bflo(s.z) * a1[0], bfhi(s.z) * a1[1]), pk2(bflo(s.w) * a1[2], bfhi(s.w) * a1[3])}; } }
        } else {
#pragma unroll
            for (int bj = 0; bj < 2; ++bj) { const int col = col0 + bj * 128;
                const f32x4 b0 = *(const GAS f32x4*)(glu_b + col), b1 = *(const GAS f32x4*)(glu_b + col + 4);
#pragma unroll
                for (int ai = 0; ai < 2; ++ai)
#pragma unroll
                    for (int m = 0; m < 4; ++m) { const size_t row = (size_t)(row0 + ai * 128 + m * 16);
                        const v4u s = *(const GAS v4u*)(Z + row * SW + col);
                        const pg8::f32x4 a0 = acc[ai][bj][m][0], a1 = acc[ai][bj][m][1];
                        *(GAS v4u*)(OA + row * SW + col) = (v4u){pk2(bflo(s.x) * sigm(a0[0] + b0[0]), bfhi(s.x) * sigm(a0[1] + b0[1])), pk2(bflo(s.y) * sigm(a0[2] + b0[2]), bfhi(s.y) * sigm(a0[3] + b0[3])),
                                                                   pk2(bflo(s.z) * sigm(a1[0] + b1[0]), bfhi(s.z) * sigm(a1[1] + b1[1])), pk2(bflo(s.w) * sigm(a1[2] + b1[2]), bfhi(s.w) * sigm(a1[3] + b1[3]))}; } }
        }
    }
};
__device__ __forceinline__ void p5_phase(const Args& A, const Frame& F) {
    P5Order S{(const char*)(A.ws + WS_GM), (const char*)(A.ws + WS_WBT), (const char*)(A.ws + WS_Z), (const char*)(A.ws + WS_GLUT), F.G, (int)blockIdx.x};
    EpiP5 E{(const bf16*)(A.ws + WS_RX), (const bf16*)(A.ws + WS_Z), A.in[15], (bf16*)(A.ws + WS_MB), (bf16*)(A.ws + WS_OA)};
    pg8::gemm_phase<EpiP5, P5Order>(F.lds, SW, S, E);
}
struct EpiP6 {
    static constexpr bool PERM = true;
    const bf16* PA; const bf16* MB; bf16* MRG;
    __device__ __forceinline__ void operator()(const pg8::f32x4 (&acc)[2][2][4][2], const pg8::Unit& u, int wr, int wc, int fr, int fq) const {
        const int row0 = u.pm * 256 + wr * 64 + fr, col0 = u.pn * 256 + wc * 32 + 8 * fq;
#pragma unroll
        for (int ai = 0; ai < 2; ++ai)
#pragma unroll
            for (int m = 0; m < 4; ++m) { const size_t row = (size_t)(row0 + ai * 128 + m * 16);
#pragma unroll
                for (int bj = 0; bj < 2; ++bj) { const int col = col0 + bj * 128;
                    const v4u s = *(const GAS v4u*)(PA + row * PW + (SW + 2 * GW) + col); const v4u q = *(const GAS v4u*)(MB + row * D + col);
                    const pg8::f32x4 a0 = acc[ai][bj][m][0], a1 = acc[ai][bj][m][1];
                    *(GAS v4u*)(MRG + row * D + col) = (v4u){pk2(bflo(s.x) * a0[0] + bflo(q.x), bfhi(s.x) * a0[1] + bfhi(q.x)), pk2(bflo(s.y) * a0[2] + bflo(q.y), bfhi(s.y) * a0[3] + bfhi(q.y)),
                                                            pk2(bflo(s.z) * a1[0] + bflo(q.z), bfhi(s.z) * a1[1] + bfhi(q.z)), pk2(bflo(s.w) * a1[2] + bflo(q.w), bfhi(s.w) * a1[3] + bfhi(q.w))}; } }
    }
};
__device__ __forceinline__ void p6_phase(const Args& A, const Frame& F) {
    DenseOrder S; S.init(A.ws + WS_OA, A.ws + WS_WAT, T, D, SW, F.G, (int)blockIdx.x);
    EpiP6 E{(const bf16*)(A.ws + WS_RX), (const bf16*)(A.ws + WS_MB), (bf16*)(A.ws + WS_MRG)};
    pg8::gemm_phase<EpiP6, DenseOrder>(F.lds, SW, S, E);
}
struct EpiP7 {
    static constexpr bool PERM = false;
    const float* x; const float* mod; float* X1;
    __device__ __forceinline__ void operator()(const pg8::f32x4 (&acc)[2][2][4][2], const pg8::Unit& u, int wr, int wc, int fr, int fq) const {
        const int row0 = u.pm * 256 + wr * 64 + fr, col0 = u.pn * 256 + wc * 32 + 4 * fq;
        const float* g1 = mod + ((u.pm * 256) / SEQ) * (NMOD * D) + 2 * D;
        f32x4 gv[2][2];
#pragma unroll
        for (int bj = 0; bj < 2; ++bj)
#pragma unroll
            for (int n = 0; n < 2; ++n) gv[bj][n] = *(const GAS f32x4*)(g1 + col0 + bj * 128 + n * 16);
#pragma unroll
        for (int ai = 0; ai < 2; ++ai)
#pragma unroll
            for (int m = 0; m < 4; ++m) { const size_t off = (size_t)(row0 + ai * 128 + m * 16) * D + col0;
#pragma unroll
                for (int bj = 0; bj < 2; ++bj)
#pragma unroll
                    for (int n = 0; n < 2; ++n) { const f32x4 xv = *(const GAS f32x4*)(x + off + bj * 128 + n * 16); *(GAS f32x4*)(X1 + off + bj * 128 + n * 16) = xv + gv[bj][n] * acc[ai][bj][m][n]; } }
    }
};
__device__ __forceinline__ void p7_phase(const Args& A, const Frame& F) {
    DenseOrder S; S.init(A.ws + WS_MRG, A.ws + WS_WOT, T, D, D, F.G, (int)blockIdx.x);
    EpiP7 E{A.in[0], (const float*)(A.ws + WS_MOD), (float*)(A.ws + WS_X1)};
    pg8::gemm_phase<EpiP7, DenseOrder>(F.lds, D, S, E);
}
constexpr size_t WS_TE = WS_SEG + 1024;
constexpr int R_STRIDE = 2064, R_HI = 0, R_LO = 16 * R_STRIDE, R_PL = 2 * 16 * R_STRIDE, R_LG = R_PL + 8 * 2048, R_HIST = R_LG + 2048, R_END = R_HIST + 128;
static_assert(R_END <= RING_BYTES, "router LDS map");
__device__ __forceinline__ void p8_phase(const Args& A, const Frame& F) {
    LAS unsigned char* lds = F.lds;
    const int lane = ((int)threadIdx.x & 63), w = F.wave, tid = ((int)threadIdx.x), fr = lane & 15, kq = lane >> 4;
    const float* mod = (const float*)(A.ws + WS_MOD);
    const float* X1 = (const float*)(A.ws + WS_X1);
    bf16* H2 = (bf16*)(A.ws + WS_H2);
    const bf16* RW = (const bf16*)(A.ws + WS_RWT);
    if (tid < 32) *(LAS int*)(lds + R_HIST + tid * 4) = 0;
    for (int tile = blockIdx.x; tile < T / 16; tile += F.G) {
#pragma unroll
        for (int i = 0; i < 2; ++i) { const int tl = 2 * w + i, t = tile * 16 + tl, b = t / SEQ;
            const GAS f32x4* xr = (const GAS f32x4*)(X1 + (size_t)t * D) + lane;
            f32x4 v[4]; float s = 0.f;
#pragma unroll
            for (int j = 0; j < 4; ++j) { v[j] = xr[64 * j]; s += (v[j].x * v[j].x + v[j].y * v[j].y) + (v[j].z * v[j].z + v[j].w * v[j].w); }
            const float r = rsqrtf(wave_sum(s) * (1.f / D) + EPS);
            const float* mb = mod + b * (NMOD * D);
#pragma unroll
            for (int j = 0; j < 4; ++j) { const f32x4 gg = ((const GAS f32x4*)A.in[23])[lane + 64 * j], sh = ((const GAS f32x4*)(mb + 3 * D))[lane + 64 * j], sc = ((const GAS f32x4*)(mb + 4 * D))[lane + 64 * j];
                const f32x4 o = v[j] * r * gg * (sc + 1.f) + sh;
                const unsigned h0 = f2bf(o.x), h1 = f2bf(o.y), h2_ = f2bf(o.z), h3 = f2bf(o.w);
                const v2u hi = (v2u){h0 | (h1 << 16), h2_ | (h3 << 16)};
                const v2u lo = (v2u){pk2(o.x - bf2f((unsigned short)h0), o.y - bf2f((unsigned short)h1)), pk2(o.z - bf2f((unsigned short)h2_), o.w - bf2f((unsigned short)h3))};
                ((GAS v2u*)(H2 + (size_t)t * D))[lane + 64 * j] = hi;
                *(LAS v2u*)(lds + R_HI + tl * R_STRIDE + (lane + 64 * j) * 8) = hi; *(LAS v2u*)(lds + R_LO + tl * R_STRIDE + (lane + 64 * j) * 8) = lo; } }
        LDS_WAIT(); __syncthreads();
        { f32x4 acc[2] = {(f32x4){0.f, 0.f, 0.f, 0.f}, (f32x4){0.f, 0.f, 0.f, 0.f}};
#pragma unroll
          for (int kk = 0; kk < 4; ++kk) { const int k0 = 128 * w + 32 * kk + 8 * kq;
              const bf16x8 hh = *(const LAS bf16x8*)(lds + R_HI + fr * R_STRIDE + k0 * 2), hl = *(const LAS bf16x8*)(lds + R_LO + fr * R_STRIDE + k0 * 2);
#pragma unroll
              for (int nb = 0; nb < 2; ++nb) { const bf16x8 wh = *(const GAS bf16x8*)(RW + (size_t)(16 * nb + fr) * D + k0), wl = *(const GAS bf16x8*)(RW + (size_t)NE * D + (size_t)(16 * nb + fr) * D + k0);
                  acc[nb] = __builtin_amdgcn_mfma_f32_16x16x32_bf16(wh, hh, acc[nb], 0, 0, 0);
                  acc[nb] = __builtin_amdgcn_mfma_f32_16x16x32_bf16(wh, hl, acc[nb], 0, 0, 0);
                  acc[nb] = __builtin_amdgcn_mfma_f32_16x16x32_bf16(wl, hh, acc[nb], 0, 0, 0); } }
#pragma unroll
          for (int nb = 0; nb < 2; ++nb) *(LAS f32x4*)(lds + R_PL + w * 2048 + fr * 128 + (16 * nb + 4 * kq) * 4) = acc[nb]; }
        LDS_WAIT(); __syncthreads();
        { const int t = tid >> 5, e = tid & 31; float lg = A.in[25][e];
#pragma unroll
          for (int q = 0; q < 8; ++q) lg += *(const LAS float*)(lds + R_PL + q * 2048 + t * 128 + e * 4);
          *(LAS float*)(lds + R_LG + t * 128 + e * 4) = lg; }
        LDS_WAIT(); __syncthreads();
        if (tid < 16) { const int t = tile * 16 + tid; const LAS float* lg = (const LAS float*)(lds + R_LG + tid * 128);
            int idx[4]; float val[4]; unsigned used = 0u;
#pragma unroll
            for (int k = 0; k < 4; ++k) { int bi = 0; float bv = -INFINITY;
                for (int e = 0; e < NE; ++e) { const float x = lg[e]; if (!((used >> e) & 1u) && x > bv) { bv = x; bi = e; } }
                used |= 1u << bi; idx[k] = bi; val[k] = bv; }
            float ex[4], den = 0.f;
#pragma unroll
            for (int k = 0; k < 4; ++k) { ex[k] = __expf(val[k] - val[0]); den += ex[k]; }
            const float inv = 1.f / den;
            *(GAS v4i*)((int*)(A.ws + WS_TOPI) + t * 4) = (v4i){idx[0], idx[1], idx[2], idx[3]};
            *(GAS f32x4*)((float*)(A.ws + WS_TOPW) + t * 4) = (f32x4){ex[0] * inv, ex[1] * inv, ex[2] * inv, ex[3] * inv};
#pragma unroll
            for (int k = 0; k < 4; ++k) __hip_atomic_fetch_add((LAS int*)(lds + R_HIST + idx[k] * 4), 1, __ATOMIC_RELAXED, __HIP_MEMORY_SCOPE_WORKGROUP); }
        LDS_WAIT(); __syncthreads();
    }
    if (tid < 32) ((int*)(A.ws + WS_ROUTE))[blockIdx.x * NE + tid] = *(LAS int*)(lds + R_HIST + tid * 4);
}

__device__ __forceinline__ void p9_phase(const Args& A, const Frame& F) {
    LAS int* li = (LAS int*)F.lds;
    const int tid = ((int)threadIdx.x), lane = ((int)threadIdx.x & 63), me = blockIdx.x;
    const int* blk = (const int*)(A.ws + WS_ROUTE);
    { const int j = tid >> 5, e = tid & 31; int tot = 0, bef = 0;
      for (int b = j; b < F.G; b += 16) { const int c = blk[b * NE + e]; tot += c; bef += (b < me) ? c : 0; }
      li[j * 32 + e] = tot; li[512 + j * 32 + e] = bef; }
    __syncthreads();
    if (tid < 32) { int tot = 0, bef = 0; for (int j = 0; j < 16; ++j) { tot += li[j * 32 + tid]; bef += li[512 + j * 32 + tid]; } li[1024 + tid] = tot; li[1056 + tid] = bef; li[1152 + tid] = 0; }
    __syncthreads();
    if (tid == 0) { int a = 0; for (int e = 0; e < NE; ++e) { li[1088 + e] = a; a += (li[1024 + e] + 255) / 256 * 256; } li[1088 + NE] = a; }
    __syncthreads();
    int* srow = (int*)(A.ws + WS_SROW); int* pos_of = (int*)(A.ws + WS_POS); const int* topi = (const int*)(A.ws + WS_TOPI);
    if (F.wave == 0) {
        for (int tile = me; tile < T / 16; tile += F.G) {
            const int t = tile * 16 + (lane >> 2), ex = topi[t * 4 + (lane & 3)];
            int rank = 0, cnt_mine = 0;
            for (int e = 0; e < NE; ++e) { const unsigned long long m = __ballot(ex == e); if (ex == e) rank = __popcll(m & ((1ull << lane) - 1ull)); if (lane == e) cnt_mine = __popcll(m); }
            const int pos = li[1088 + ex] + li[1056 + ex] + li[1152 + ex] + rank;
            pos_of[t * 4 + (lane & 3)] = pos; srow[pos] = t;
            asm volatile("s_waitcnt lgkmcnt(0)" ::: "memory");
            if (lane < 32) li[1152 + lane] += cnt_mine;
            asm volatile("s_waitcnt lgkmcnt(0)" ::: "memory");
        }
    }
    for (int e = me; e < NE; e += F.G) { const int p0 = li[1088 + e] + li[1024 + e], p1 = li[1088 + e + 1]; for (int r = p0 + tid; r < p1; r += NTHREADS) srow[r] = 0; }
    if (me == 0) { if (tid <= NE) ((int*)(A.ws + WS_SEG))[tid] = li[1088 + tid];
        const int nt = li[1088 + NE] / 256; for (int r = tid; r < nt; r += NTHREADS) { int e = 0; for (int j = 1; j < NE; ++j) e = (r * 256 >= li[1088 + j]) ? j : e; ((int*)(A.ws + WS_TE))[r] = e; } }
    __syncthreads();
}

struct MoeOrder1 {
    const char* H2; const char* W1T; const int* srow; const int* te; int NT, G, c;
    __device__ __forceinline__ bool next(int i, pg8::Unit& u) const {
        const int L = i * G + c, rt = L >> 3, ct = L & 7; if (rt >= NT) return false;
        const int e = te[rt]; u.pm = rt; u.pn = ct; u.aux = e; u.abase = H2;
        u.b0 = W1T + ((size_t)e * 2 * DE + ct * 128) * D * 2; u.b1 = u.b0 + (size_t)DE * D * 2; return true;
    }
    static constexpr bool GATHER = true;
    __device__ __forceinline__ void aoff(const pg8::Unit& u, const int (&R)[2], const int (&C)[2], unsigned (&va)[2][2]) const {
#pragma unroll
        for (int h = 0; h < 2; ++h)
#pragma unroll
            for (int i = 0; i < 2; ++i) va[h][i] = (unsigned)(srow[u.pm * 256 + h * 128 + R[i]] * D + C[i]) * 2u;
    }
};
struct EpiSwiglu {
    static constexpr bool PERM = true;
    const float* b_in; bf16* ACT;
    __device__ __forceinline__ void operator()(const pg8::f32x4 (&acc)[2][2][4][2], const pg8::Unit& u, int wr, int wc, int fr, int fq) const {
        const int row0 = u.pm * 256 + wr * 64 + fr, col = u.pn * 128 + wc * 32 + 8 * fq;
        const float* bi = b_in + (size_t)u.aux * 2 * DE + col;
        const f32x4 bg0 = *(const GAS f32x4*)bi, bg1 = *(const GAS f32x4*)(bi + 4), bu0 = *(const GAS f32x4*)(bi + DE), bu1 = *(const GAS f32x4*)(bi + DE + 4);
#pragma unroll
        for (int ai = 0; ai < 2; ++ai)
#pragma unroll
            for (int m = 0; m < 4; ++m) { float o[8];
#pragma unroll
                for (int j = 0; j < 8; ++j) { const float gt = fminf(acc[ai][0][m][j >> 2][j & 3] + (j < 4 ? bg0[j & 3] : bg1[j & 3]), 7.f);
                    const float up = fminf(fmaxf(acc[ai][1][m][j >> 2][j & 3] + (j < 4 ? bu0[j & 3] : bu1[j & 3]), -7.f), 7.f);
                    o[j] = (up + 1.f) * (gt * sigm(1.702f * gt)); }
                *(GAS v4u*)(ACT + (size_t)(row0 + ai * 128 + m * 16) * DE + col) = (v4u){pk2(o[0], o[1]), pk2(o[2], o[3]), pk2(o[4], o[5]), pk2(o[6], o[7])}; }
    }
};
__device__ __forceinline__ void p10_phase(const Args& A, const Frame& F) {
    const int NT = ((const int*)(A.ws + WS_SEG))[NE] / 256;
    MoeOrder1 S{(const char*)(A.ws + WS_H2), (const char*)(A.ws + WS_W1T), (const int*)(A.ws + WS_SROW), (const int*)(A.ws + WS_TE), NT, F.G, F.vcu};
    EpiSwiglu E{A.in[27], (bf16*)(A.ws + WS_RX)};
    pg8::gemm_phase<EpiSwiglu, MoeOrder1>(F.lds, D, S, E);
}
struct MoeOrder2 {
    const char* ACT; const char* W2T; const int* te; int NT, G, c;
    __device__ __forceinline__ bool next(int i, pg8::Unit& u) const {
        const int L = i * G + c, rt = L >> 2, ct = L & 3; if (rt >= NT) return false;
        const int e = te[rt]; u.pm = rt; u.pn = ct; u.aux = e; u.abase = ACT + (size_t)rt * 256 * DE * 2;
        u.b0 = W2T + ((size_t)e * D + ct * 256) * DE * 2; u.b1 = u.b0 + (size_t)128 * DE * 2; return true;
    }
    static constexpr bool GATHER = false;
    __device__ __forceinline__ void aoff(const pg8::Unit&, const int (&R)[2], const int (&C)[2], unsigned (&va)[2][2]) const {
#pragma unroll
        for (int h = 0; h < 2; ++h)
#pragma unroll
            for (int i = 0; i < 2; ++i) va[h][i] = (unsigned)((h * 128 + R[i]) * DE + C[i]) * 2u;
    }
};
struct EpiMoe2 {
    static constexpr bool PERM = true;
    const float* b_out; bf16* YS;
    __device__ __forceinline__ void operator()(const pg8::f32x4 (&acc)[2][2][4][2], const pg8::Unit& u, int wr, int wc, int fr, int fq) const {
        const int row0 = u.pm * 256 + wr * 64 + fr, col0 = u.pn * 256 + wc * 32 + 8 * fq;
#pragma unroll
        for (int bj = 0; bj < 2; ++bj) { const int col = col0 + bj * 128; const float* bo = b_out + (size_t)u.aux * D + col;
            const f32x4 b0 = *(const GAS f32x4*)bo, b1 = *(const GAS f32x4*)(bo + 4);
#pragma unroll
            for (int ai = 0; ai < 2; ++ai)
#pragma unroll
                for (int m = 0; m < 4; ++m) { const pg8::f32x4 a0 = acc[ai][bj][m][0] + b0, a1 = acc[ai][bj][m][1] + b1;
                    *(GAS v4u*)(YS + (size_t)(row0 + ai * 128 + m * 16) * D + col) = (v4u){pk2(a0[0], a0[1]), pk2(a0[2], a0[3]), pk2(a1[0], a1[1]), pk2(a1[2], a1[3])}; } }
    }
};
__device__ __forceinline__ void p11_phase(const Args& A, const Frame& F) {
    const int NT = ((const int*)(A.ws + WS_SEG))[NE] / 256;
    MoeOrder2 S{(const char*)(A.ws + WS_RX), (const char*)(A.ws + WS_W2T), (const int*)(A.ws + WS_TE), NT, F.G, F.vcu};
    EpiMoe2 E{A.in[29], (bf16*)(A.ws + WS_RY)};
    pg8::gemm_phase<EpiMoe2, MoeOrder2>(F.lds, DE, S, E);
}
__device__ __forceinline__ void p12_phase(const Args& A, const Frame& F) {
    const int gw = F.vcu * NWAVES + F.wave, NGW = F.G * NWAVES, lane = ((int)threadIdx.x & 63);
    const float* mod = (const float*)(A.ws + WS_MOD); const float* X1 = (const float*)(A.ws + WS_X1); const bf16* YS = (const bf16*)(A.ws + WS_RY);
    for (int t = gw; t < T; t += NGW) { const int b = t / SEQ;
        const v4i ps = *(const GAS v4i*)((const int*)(A.ws + WS_POS) + t * 4); const f32x4 wt = *(const GAS f32x4*)((const float*)(A.ws + WS_TOPW) + t * 4);
        const int pp[4] = {ps.x, ps.y, ps.z, ps.w};
        f32x4 o[4]; float s = 0.f;
#pragma unroll
        for (int j = 0; j < 4; ++j) { f32x4 m = {0.f, 0.f, 0.f, 0.f};
#pragma unroll
            for (int k = 0; k < 4; ++k) { const v2u y = ((const GAS v2u*)(YS + (size_t)pp[k] * D))[lane + 64 * j]; const float wk = wt[k];
                m[0] += wk * bflo(y.x); m[1] += wk * bfhi(y.x); m[2] += wk * bflo(y.y); m[3] += wk * bfhi(y.y); }
            const f32x4 xv = ((const GAS f32x4*)(X1 + (size_t)t * D))[lane + 64 * j], g2 = ((const GAS f32x4*)(mod + b * (NMOD * D) + 5 * D))[lane + 64 * j];
            o[j] = xv + g2 * m; s += (o[j].x * o[j].x + o[j].y * o[j].y) + (o[j].z * o[j].z + o[j].w * o[j].w); }
        const float r = rsqrtf(wave_sum(s) * (1.f / D) + EPS);
#pragma unroll
        for (int j = 0; j < 4; ++j) { const f32x4 fg = ((const GAS f32x4*)A.in[30])[lane + 64 * j]; ((GAS f32x4*)(A.out + (size_t)t * D))[lane + 64 * j] = o[j] * r * fg; }
    }
}
constexpr int NPHASE = 13;
__global__ void __launch_bounds__(NTHREADS, 2) mega(Args args) {
    extern __shared__ __attribute__((aligned(16))) unsigned char lds_[];
    Frame F;
    F.lds = (LAS unsigned char*)lds_;
    F.wave = __builtin_amdgcn_readfirstlane((int)threadIdx.x >> 6);
    F.G = gridDim.x; { const int bx = blockIdx.x; F.vcu = (F.G % 8 == 0) ? (bx % 8) * (F.G / 8) + bx / 8 : bx; }
    for (int u = threadIdx.x; u < (LDS_BYTES - LDSCTL_OFF) / 4; u += NTHREADS) ((LAS unsigned*)(F.lds + LDSCTL_OFF))[u] = 0u;
    __syncthreads();
    XcdBarrier bar = xcd_barrier_post((unsigned*)(args.ws + WS_CTL) + CW_BAR, (volatile LAS unsigned*)(F.lds + MISC_OFF) + 8);
    const int lo = args.ph_lo, hi = args.ph_hi;
#define IN(k) (lo <= (k) && (k) < hi)
#define SEAM(k) do { if (IN(k) && IN((k) + 1)) xcd_barrier(bar); } while (0)
    if (IN(0)) { p0_prologue(args, F); } SEAM(0);
    if (IN(1)) { p1_h1(args, F); } SEAM(1);
    if (IN(2)) { p2_proj(args, F); } SEAM(2);
    if (IN(3)) { p3_phase(args, F); } SEAM(3);
    if (IN(4)) { p4_phase(args, F); } SEAM(4);
    if (IN(5)) { p5_phase(args, F); } SEAM(5);
    if (IN(6)) { p6_phase(args, F); } SEAM(6);
    if (IN(7)) { p7_phase(args, F); } SEAM(7);
    if (IN(8)) { p8_phase(args, F); } SEAM(8);
    if (IN(9)) { p9_phase(args, F); } SEAM(9);
    if (IN(10)) { p10_phase(args, F); } SEAM(10);
    if (IN(11)) { p11_phase(args, F); } SEAM(11);
    if (IN(12)) { p12_phase(args, F); }
#undef IN
#undef SEAM
}
}
namespace nv {

__device__ __forceinline__ float sigmoidf_(float x) { return 1.f / (1.f + __expf(-x)); }
__device__ __forceinline__ float gelu_tanh(float x) { const float u = 0.7978845608028654f * (x + 0.044715f * x * x * x); return 0.5f * x * (1.f + tanhf(u)); }

__device__ __forceinline__ float block_sum_256(float v, float* sm) {
#pragma unroll
    for (int o = 32; o > 0; o >>= 1) v += __shfl_xor(v, o);
    __syncthreads();
    if ((threadIdx.x & 63) == 0) sm[threadIdx.x >> 6] = v;
    __syncthreads();
    return sm[0] + sm[1] + sm[2] + sm[3];
}

__global__ void k_mod(const float* __restrict__ c, const float* __restrict__ ada_w, const float* __restrict__ ada_b, float* __restrict__ mod) {
    const int j = blockIdx.x * blockDim.x + threadIdx.x, b = blockIdx.y;
    float acc = ada_b[j];
    for (int k = 0; k < D; ++k) { const float cv = c[b * D + k]; acc += cv * sigmoidf_(cv) * ada_w[(size_t)k * (NMOD * D) + j]; }
    mod[b * (NMOD * D) + j] = acc;
}

__global__ void k_norm_mod(const float* __restrict__ x, const float* __restrict__ g, const float* __restrict__ mod, int shift_off, int scale_off, float* __restrict__ h) {
    __shared__ float sm[8];
    const int t = blockIdx.x, b = t / SEQ;
    const float4 v = ((const float4*)(x + (size_t)t * D))[threadIdx.x];
    const float ss = block_sum_256(v.x * v.x + v.y * v.y + v.z * v.z + v.w * v.w, sm);
    const float r = rsqrtf(ss * (1.f / D) + EPS);
    const int d0 = threadIdx.x * 4;
    const float* mb = mod + b * (NMOD * D);
    float o[4] = {v.x, v.y, v.z, v.w};
#pragma unroll
    for (int i = 0; i < 4; ++i) o[i] = o[i] * r * g[d0 + i] * (1.f + mb[scale_off + d0 + i]) + mb[shift_off + d0 + i];
    ((float4*)(h + (size_t)t * D))[threadIdx.x] = make_float4(o[0], o[1], o[2], o[3]);
}

template <bool DUAL, class AF, class EF>
__device__ __forceinline__ void sgemm_tile(int m0, int n0, int K, const float* __restrict__ Bm, int ldb, int dual_off, AF af, EF ef) {
    __shared__ float As[16][68], Bs[16][68], Bs2[DUAL ? 16 : 1][68];
    const int tid = threadIdx.x, tx = tid & 15, ty = tid >> 4;
    float acc[4][4], acc2[4][4];
#pragma unroll
    for (int i = 0; i < 4; ++i)
#pragma unroll
        for (int j = 0; j < 4; ++j) { acc[i][j] = 0.f; acc2[i][j] = 0.f; }
    for (int k0 = 0; k0 < K; k0 += 16) {
#pragma unroll
        for (int q = 0; q < 4; ++q) { const int idx = tid + q * 256, m = idx >> 4, k = idx & 15; As[k][m] = af(m0 + m, k0 + k); }
#pragma unroll
        for (int q = 0; q < 4; ++q) { const int idx = tid + q * 256, k = idx >> 6, n = idx & 63; Bs[k][n] = Bm[(size_t)(k0 + k) * ldb + n0 + n];
            if (DUAL) Bs2[k][n] = Bm[(size_t)(k0 + k) * ldb + n0 + n + dual_off]; }
        __syncthreads();
#pragma unroll
        for (int k = 0; k < 16; ++k) {
            float a[4], b[4], b2[4];
#pragma unroll
            for (int i = 0; i < 4; ++i) a[i] = As[k][ty * 4 + i];
#pragma unroll
            for (int j = 0; j < 4; ++j) { b[j] = Bs[k][tx * 4 + j]; b2[j] = DUAL ? Bs2[k][tx * 4 + j] : 0.f; }
#pragma unroll
            for (int i = 0; i < 4; ++i)
#pragma unroll
                for (int j = 0; j < 4; ++j) { acc[i][j] += a[i] * b[j]; if (DUAL) acc2[i][j] += a[i] * b2[j]; }
        }
        __syncthreads();
    }
#pragma unroll
    for (int i = 0; i < 4; ++i)
#pragma unroll
        for (int j = 0; j < 4; ++j) ef(m0 + ty * 4 + i, n0 + tx * 4 + j, acc[i][j], acc2[i][j]);
}

__global__ void k_gemm_plain(const float* __restrict__ A, int lda, const float* __restrict__ Bm, int ldb, float* __restrict__ C, int ldc, int K) {
    const int m0 = blockIdx.y * 64, n0 = blockIdx.x * 64;
    sgemm_tile<false>(m0, n0, K, Bm, ldb, 0, [&](int m, int k) { return A[(size_t)m * lda + k]; },
                      [&](int m, int n, float a, float) { C[(size_t)m * ldc + n] = a; });
}
__global__ void k_gemm_glu(const float* __restrict__ Z, const float* __restrict__ W, const float* __restrict__ bias, float* __restrict__ O) {
    const int m0 = blockIdx.y * 64, n0 = blockIdx.x * 64;
    sgemm_tile<false>(m0, n0, SW, W, SW, 0, [&](int m, int k) { return Z[(size_t)m * SW + k]; },
                      [&](int m, int n, float a, float) { O[(size_t)m * SW + n] = Z[(size_t)m * SW + n] * sigmoidf_(a + bias[n]); });
}
template <bool PRE> __global__ void k_gemm_branch(const float* __restrict__ A, const float* __restrict__ W, const float* __restrict__ proj, int gate_off, float* __restrict__ merged, int accumulate) {
    const int m0 = blockIdx.y * 64, n0 = blockIdx.x * 64;
    sgemm_tile<false>(m0, n0, SW, W, D, 0, [&](int m, int k) { return A[(size_t)m * SW + k]; },
                      [&](int m, int n, float a, float) { const float gv = proj[(size_t)m * PW + gate_off + n]; const float v = (PRE ? gv : sigmoidf_(gv)) * a;
                          float* p = merged + (size_t)m * D + n; *p = accumulate ? (*p + v) : v; });
}
__global__ void k_gemm_out(const float* __restrict__ merged, const float* __restrict__ W, const float* __restrict__ x, const float* __restrict__ mod, float* __restrict__ x1) {
    const int m0 = blockIdx.y * 64, n0 = blockIdx.x * 64;
    sgemm_tile<false>(m0, n0, D, W, D, 0, [&](int m, int k) { return merged[(size_t)m * D + k]; },
                      [&](int m, int n, float a, float) { const int b = m / SEQ; x1[(size_t)m * D + n] = x[(size_t)m * D + n] + mod[b * (NMOD * D) + 2 * D + n] * a; });
}

__global__ void k_s5(const float* __restrict__ proj, const float* __restrict__ a_re, const float* __restrict__ a_im, const float* __restrict__ log_dt,
                     const float* __restrict__ b_re, const float* __restrict__ b_im, const float* __restrict__ c_re, const float* __restrict__ c_im,
                     const float* __restrict__ dskip, float* __restrict__ z) {
    __shared__ float s_re[64], s_im[64], cre[16][65], cim[16][65];
    const int p = threadIdx.x, b = blockIdx.x / NG, g = blockIdx.x % NG;
    const double dt = exp((double)log_dt[g]);
    const double lr = a_re[g * NP + p], li = a_im[g * NP + p];
    const double mag = exp(lr * dt), lbr_d = mag * cos(li * dt), lbi_d = mag * sin(li * dt);
    const double nr = lbr_d - 1.0, ni = lbi_d, den = lr * lr + li * li;
    const double cfr = (nr * lr + ni * li) / den, cfi = (ni * lr - nr * li) / den;
    const float lbr = (float)lbr_d, lbi = (float)lbi_d;
    float bbr[16], bbi[16];
#pragma unroll
    for (int h = 0; h < 16; ++h) { const double br = b_re[(g * NP + p) * NHC + h], bi = b_im[(g * NP + p) * NHC + h];
        bbr[h] = (float)(cfr * br - cfi * bi); bbi[h] = (float)(cfr * bi + cfi * br); }
    for (int i = p; i < 16 * 64; i += 64) { const int ho = i / 64, pp = i % 64; cre[ho][pp] = c_re[(g * NHC + ho) * NP + pp]; cim[ho][pp] = c_im[(g * NHC + ho) * NP + pp]; }
    __syncthreads();
    float sr = 0.f, si = 0.f;
    const float dsk = (p < 16) ? dskip[g * NHC + p] : 0.f;
    for (int s = 0; s < SEQ; ++s) {
        const size_t t = (size_t)b * SEQ + s;
        const float4* up = (const float4*)(proj + t * PW + g * NHC);
        const float4 u0 = up[0], u1 = up[1], u2 = up[2], u3 = up[3];
        const float u[16] = {u0.x, u0.y, u0.z, u0.w, u1.x, u1.y, u1.z, u1.w, u2.x, u2.y, u2.z, u2.w, u3.x, u3.y, u3.z, u3.w};
        float br = 0.f, bi = 0.f;
#pragma unroll
        for (int h = 0; h < 16; ++h) { br += bbr[h] * u[h]; bi += bbi[h] * u[h]; }
        const float nsr = lbr * sr - lbi * si + br, nsi = lbr * si + lbi * sr + bi;
        sr = nsr; si = nsi;
        s_re[p] = sr; s_im[p] = si;
        __syncthreads();
        if (p < 16) {
            float y = 0.f;
            for (int pp = 0; pp < 64; ++pp) y += cre[p][pp] * s_re[pp] - cim[p][pp] * s_im[pp];
            float up_ = 0.f;
#pragma unroll
            for (int h = 0; h < 16; ++h) up_ = (h == p) ? u[h] : up_;
            y += dsk * up_;
            z[t * SW + g * NHC + p] = gelu_tanh(y);
        }
        __syncthreads();
    }
}

template <bool PRE> __global__ void k_gmlp_ln(const float* __restrict__ proj, const float* __restrict__ lng, const float* __restrict__ lnb, float* __restrict__ gu, float* __restrict__ vn) {
    __shared__ float sm[8];
    const int t = blockIdx.x, i0 = threadIdx.x * 2;
    const float* pr = proj + (size_t)t * PW + SW;
    const float a0 = PRE ? pr[i0] : gelu_tanh(pr[i0]), a1 = PRE ? pr[i0 + 1] : gelu_tanh(pr[i0 + 1]);
    const float v0 = PRE ? pr[GW + i0] : gelu_tanh(pr[GW + i0]), v1 = PRE ? pr[GW + i0 + 1] : gelu_tanh(pr[GW + i0 + 1]);
    gu[(size_t)t * GW + i0] = a0; gu[(size_t)t * GW + i0 + 1] = a1;
    const float mu = block_sum_256(v0 + v1, sm) * (1.f / GW);
    const float d0 = v0 - mu, d1 = v1 - mu;
    const float var = block_sum_256(d0 * d0 + d1 * d1, sm) * (1.f / GW);
    const float r = rsqrtf(var + EPS);
    vn[(size_t)t * GW + i0] = d0 * r * lng[i0] + lnb[i0];
    vn[(size_t)t * GW + i0 + 1] = d1 * r * lng[i0 + 1] + lnb[i0 + 1];
}
__global__ void k_gmlp_mix(const float* __restrict__ gu, const float* __restrict__ vn, const float* __restrict__ ws, const float* __restrict__ bs, float* __restrict__ gm) {
    const int blk = blockIdx.x, sub = blk & 31, h = (blk >> 5) & 7, chunk = blk >> 8;
    const int tl = sub * 4 + (threadIdx.x >> 6), c = threadIdx.x & 63;
    const float* w = ws + ((size_t)h * CHUNK + tl) * CHUNK;
    const float* v = vn + (size_t)chunk * CHUNK * GW + h * HD + c;
    float acc = 0.f;
    for (int s = 0; s <= tl; ++s) acc += w[s] * v[(size_t)s * GW];
    const size_t o = ((size_t)chunk * CHUNK + tl) * GW + h * HD + c;
    gm[o] = gu[o] * (acc + bs[h * CHUNK + tl]);
}

__global__ void k_router(const float* __restrict__ x1, const float* __restrict__ g2, const float* __restrict__ mod, const float* __restrict__ rw, const float* __restrict__ rb,
                         float* __restrict__ h2, int* __restrict__ topi, float* __restrict__ topw) {
    __shared__ float sm[8], hs[D], part[8][32], lg[32];
    const int t = blockIdx.x, b = t / SEQ;
    const float4 v = ((const float4*)(x1 + (size_t)t * D))[threadIdx.x];
    const float ss = block_sum_256(v.x * v.x + v.y * v.y + v.z * v.z + v.w * v.w, sm);
    const float r = rsqrtf(ss * (1.f / D) + EPS);
    const int d0 = threadIdx.x * 4;
    const float* mb = mod + b * (NMOD * D);
    float o[4] = {v.x, v.y, v.z, v.w};
#pragma unroll
    for (int i = 0; i < 4; ++i) { o[i] = o[i] * r * g2[d0 + i] * (1.f + mb[4 * D + d0 + i]) + mb[3 * D + d0 + i]; hs[d0 + i] = o[i]; }
    ((float4*)(h2 + (size_t)t * D))[threadIdx.x] = make_float4(o[0], o[1], o[2], o[3]);
    __syncthreads();
    { const int e = threadIdx.x & 31, q = threadIdx.x >> 5; float a = 0.f;
      for (int k = q * 128; k < q * 128 + 128; ++k) a += hs[k] * rw[k * NE + e];
      part[q][e] = a; }
    __syncthreads();
    if (threadIdx.x < 32) { float a = rb[threadIdx.x]; for (int q = 0; q < 8; ++q) a += part[q][threadIdx.x]; lg[threadIdx.x] = a; }
    __syncthreads();
    if (threadIdx.x == 0) {
        int idx[4]; float val[4]; unsigned used = 0u;
        for (int k = 0; k < 4; ++k) { int bi = -1; float bv = -INFINITY; for (int e = 0; e < NE; ++e) if (!((used >> e) & 1u) && lg[e] > bv) { bv = lg[e]; bi = e; } used |= 1u << bi; idx[k] = bi; val[k] = bv; }
        float den = 0.f, ex[4];
        for (int k = 0; k < 4; ++k) { ex[k] = __expf(val[k] - val[0]); den += ex[k]; }
        for (int k = 0; k < 4; ++k) { topi[t * 4 + k] = idx[k]; topw[t * 4 + k] = ex[k] / den; }
    }
}

__global__ void k_route(const int* __restrict__ topi, const float* __restrict__ topw, int* __restrict__ seg, int* __restrict__ srow_tok, float* __restrict__ srow_w, int* __restrict__ pos_of) {
    __shared__ int cnt[NE], st[NE + 1];
    const int e = threadIdx.x;
    int c = 0;
    for (int i = 0; i < T * TOPK; ++i) c += (topi[i] == e);
    cnt[e] = c;
    __syncthreads();
    if (e == 0) { int a = 0; for (int j = 0; j < NE; ++j) { st[j] = a; a += (cnt[j] + 255) / 256 * 256; } st[NE] = a; }
    __syncthreads();
    seg[e] = st[e]; if (e == 0) seg[NE] = st[NE];
    int pos = st[e];
    for (int i = 0; i < T * TOPK; ++i) if (topi[i] == e) { srow_tok[pos] = i >> 2; srow_w[pos] = topw[i]; pos_of[i] = pos; ++pos; }
}

__device__ __forceinline__ int find_expert(const int* __restrict__ seg, int row) { int e = 0; for (int j = 1; j < NE; ++j) e = (row >= seg[j]) ? j : e; return e; }

__global__ void k_moe1(const float* __restrict__ h2, const int* __restrict__ seg, const int* __restrict__ srow_tok, const float* __restrict__ w_in, const float* __restrict__ b_in, float* __restrict__ act) {
    const int m0 = blockIdx.y * 64, n0 = blockIdx.x * 64;
    if (m0 >= seg[NE]) return;
    const int e = find_expert(seg, m0);
    const float* W = w_in + (size_t)e * D * 2 * DE; const float* bi = b_in + (size_t)e * 2 * DE;
    sgemm_tile<true>(m0, n0, D, W, 2 * DE, DE, [&](int m, int k) { const int tk = srow_tok[m]; return tk >= 0 ? h2[(size_t)tk * D + k] : 0.f; },
                     [&](int m, int n, float ag, float au) { float gt = fminf(ag + bi[n], 7.f); float up = fminf(fmaxf(au + bi[DE + n], -7.f), 7.f);
                         act[(size_t)m * DE + n] = (up + 1.f) * (gt * sigmoidf_(1.702f * gt)); });
}
__global__ void k_moe2(const float* __restrict__ act, const int* __restrict__ seg, const float* __restrict__ srow_w, const float* __restrict__ w_out, const float* __restrict__ b_out, float* __restrict__ ys) {
    const int m0 = blockIdx.y * 64, n0 = blockIdx.x * 64;
    if (m0 >= seg[NE]) return;
    const int e = find_expert(seg, m0);
    const float* W = w_out + (size_t)e * DE * D; const float* bo = b_out + (size_t)e * D;
    sgemm_tile<false>(m0, n0, DE, W, D, 0, [&](int m, int k) { return act[(size_t)m * DE + k]; },
                      [&](int m, int n, float a, float) { ys[(size_t)m * D + n] = (a + bo[n]) * srow_w[m]; });
}
__global__ void k_final(const float* __restrict__ x1, const float* __restrict__ ys, const int* __restrict__ pos_of, const float* __restrict__ mod, const float* __restrict__ fg, float* __restrict__ out) {
    __shared__ float sm[8];
    const int t = blockIdx.x, b = t / SEQ, d0 = threadIdx.x * 4;
    const float4 xv = ((const float4*)(x1 + (size_t)t * D))[threadIdx.x];
    float m[4] = {0.f, 0.f, 0.f, 0.f};
    for (int k = 0; k < 4; ++k) { const float4 y = ((const float4*)(ys + (size_t)pos_of[t * 4 + k] * D))[threadIdx.x]; m[0] += y.x; m[1] += y.y; m[2] += y.z; m[3] += y.w; }
    const float* g2 = mod + b * (NMOD * D) + 5 * D + d0;
    float o[4] = {xv.x + g2[0] * m[0], xv.y + g2[1] * m[1], xv.z + g2[2] * m[2], xv.w + g2[3] * m[3]};
    const float ss = block_sum_256(o[0] * o[0] + o[1] * o[1] + o[2] * o[2] + o[3] * o[3], sm);
    const float r = rsqrtf(ss * (1.f / D) + EPS);
    ((float4*)(out + (size_t)t * D))[threadIdx.x] = make_float4(o[0] * r * fg[d0], o[1] * r * fg[d0 + 1], o[2] * r * fg[d0 + 2], o[3] * r * fg[d0 + 3]);
}

__global__ void k_bf16_to_f32(const unsigned short* __restrict__ s, float* __restrict__ d, size_t n) { for (size_t i = (size_t)blockIdx.x * blockDim.x + threadIdx.x; i < n; i += (size_t)gridDim.x * blockDim.x) d[i] = __builtin_bit_cast(float, (unsigned)s[i] << 16); }
}
#ifndef REP_PHASE
#define REP_PHASE -1
#define REP_PHASE2 -1
#endif
static int launch_mega(const Args& a0, int lo, int hi, hipStream_t stream) {
    static int grid = 0;
    if (grid == 0) {
        int dev = 0, cus = 0, per_cu = 0;
        if (hipGetDevice(&dev) != hipSuccess || hipDeviceGetAttribute(&cus, hipDeviceAttributeMultiprocessorCount, dev) != hipSuccess) { fprintf(stderr, "kernel_launch: device query failed\n"); grid = -1; return -1; }
        if (hipFuncSetAttribute((const void*)mega, hipFuncAttributeMaxDynamicSharedMemorySize, LDS_BYTES) != hipSuccess) { fprintf(stderr, "kernel_launch: hipFuncSetAttribute failed\n"); grid = -1; return -1; }
        if (hipOccupancyMaxActiveBlocksPerMultiprocessor(&per_cu, (const void*)mega, NTHREADS, LDS_BYTES) != hipSuccess || per_cu < 1) { fprintf(stderr, "kernel_launch: occupancy query says %d blocks per CU\n", per_cu); per_cu = 1; }
        (void)hipGetLastError();
        grid = cus;
    }
    if (grid < 0) return -1;
    Args a = a0; a.ph_lo = lo; a.ph_hi = hi; a.rep = -1; a.pad = 0;
    hipLaunchKernelGGL(mega, dim3(grid), dim3(NTHREADS), LDS_BYTES, stream, a);
    return 0;
}

extern "C" void kernel_launch(void* const* d_in, const int* in_sizes, int n_in, void* d_out, int out_size, void* d_ws, size_t ws_size, hipStream_t stream) {
    if (n_in != 31 || ws_size < 1000 * MiB) { fprintf(stderr, "kernel_launch: unexpected inputs (n_in %d, ws %zu)\n", n_in, ws_size); return; }
    Args a{};
    for (int i = 0; i < 31; ++i) a.in[i] = (const float*)d_in[i];
    a.out = (float*)d_out; a.ws = (unsigned char*)d_ws;
    (void)hipMemsetAsync((char*)d_ws + WS_CTL, 0, CTL_ZERO_BYTES, stream);
    char* ws = (char*)d_ws;
    const float* x = a.in[0];
    float* out = (float*)d_out;
    launch_mega(a, 0, NPHASE, stream);
#if REP_PHASE >= 0
    launch_mega(a, REP_PHASE, REP_PHASE2 + 1, stream);
#endif
}
```

```cpp
#include <hip/hip_runtime.h>
#include <cstdio>
#include <cstdint>
namespace pg8 {
#define PG8_LAS __attribute__((address_space(3)))
typedef unsigned short bf16_t;
typedef short bf16x8 __attribute__((ext_vector_type(8)));
typedef float f32x4 __attribute__((ext_vector_type(4)));
typedef float f32x2 __attribute__((ext_vector_type(2)));
typedef unsigned u32x4 __attribute__((ext_vector_type(4)));
typedef unsigned u32x2 __attribute__((ext_vector_type(2)));
constexpr int BM = 256, BK = 64, HALF = 128, HTB = HALF * BK * 2  , STAGE_BYTES = 8 * HTB, NXCD = 8, WGM = 8;
constexpr int VN_SLOT_OFF = STAGE_BYTES + 1024;

__host__ __device__ __forceinline__ int lds_byte(int r, int c) { const int st = (r >> 4) * 2 + (c >> 5), rr = r & 15, cc = c & 31, ob = rr * 64 + cc * 2; return st * 1024 + (ob ^ (((ob >> 9) & 1) << 5)); }
__host__ __device__ __forceinline__ void stage_rc(int b, int& R, int& C) { const int st = b / 1024, sb = b % 1024, swz = sb ^ (((sb >> 9) & 1) << 5); R = (st >> 1) * 16 + swz / 64; C = (st & 1) * 32 + (swz % 64) / 2; }
__host__ __device__ __forceinline__ int perm32(int rho) { const int n = rho >> 4, i = rho & 15; return 8 * (i >> 2) + 4 * n + (i & 3); }

struct Unit { int pm, pn, aux; const char* abase; const char* b0; const char* b1; };

__device__ __forceinline__ unsigned cvt_pk_bf16(float lo, float hi) { unsigned r; asm volatile("v_cvt_pk_bf16_f32 %0, %1, %2" : "=v"(r) : "v"(lo), "v"(hi)); return r; }

template <class Epi, class Sched>
__device__ __forceinline__ void gemm_phase(PG8_LAS unsigned char* lds, const int K, const Sched& S, const Epi& E) {
    const int tid = threadIdx.x, wid = __builtin_amdgcn_readfirstlane(tid >> 6), lane = tid & 63, wr = wid >> 2, wc = wid & 3, fr = lane & 15, fq = lane >> 4;
    const int nt = K / BK;
    int Rp[2], Cp[2]; unsigned voffB[2];
#pragma unroll
    for (int i = 0; i < 2; ++i) { int R, C; stage_rc(tid * 16 + i * 8192, R, C); Rp[i] = R; Cp[i] = C; const int Rb = Epi::PERM ? ((R & ~31) + perm32(R & 31)) : R; voffB[i] = (unsigned)(Rb * K + C) * 2u; }
    const size_t kstep = (size_t)(BK * 2);
    const unsigned ldsw = (unsigned)wid * 1024u;
    const int aoff = lds_byte(wr * 64 + fr, fq * 8), boff = lds_byte(wc * 32 + fr, fq * 8);
#define PG8_SA(b, h) (((b) * 2 + (h)) * HTB)
#define PG8_SB(b, h) ((4 + (b) * 2 + (h)) * HTB)
#define PG8_STAGE(bufoff, gbase, voff) do { _Pragma("unroll") for (int _i = 0; _i < 2; ++_i) \
        __builtin_amdgcn_global_load_lds((const unsigned*)((const char*)(gbase) + (voff)[_i]), (PG8_LAS unsigned*)(lds + (bufoff) + ldsw + _i * 8192), 16, 0, 0); } while (0)
#define PG8_LDA(dst, b, h) do { _Pragma("unroll") for (int m = 0; m < 4; ++m) _Pragma("unroll") for (int k = 0; k < 2; ++k) dst[m][k] = *(const PG8_LAS bf16x8*)(lds + PG8_SA(b, h) + aoff + m * 2048 + k * 1024); } while (0)
#define PG8_LDB(dst, b, h) do { _Pragma("unroll") for (int n = 0; n < 2; ++n) _Pragma("unroll") for (int k = 0; k < 2; ++k) dst[n][k] = *(const PG8_LAS bf16x8*)(lds + PG8_SB(b, h) + boff + n * 2048 + k * 1024); } while (0)
#define PG8_MMA(ai, bj, At, Bt) do { __builtin_amdgcn_s_setprio(1); _Pragma("unroll") for (int m = 0; m < 4; ++m) _Pragma("unroll") for (int n = 0; n < 2; ++n) _Pragma("unroll") for (int k = 0; k < 2; ++k) \
        acc[ai][bj][m][n] = __builtin_amdgcn_mfma_f32_16x16x32_bf16(Bt[n][k], At[m][k], acc[ai][bj][m][n], 0, 0, 0); __builtin_amdgcn_s_setprio(0); } while (0)
#define PG8_WAIT_V(n) asm volatile("s_waitcnt vmcnt(" #n ")" ::: "memory")
#define PG8_WAIT_L(n) asm volatile("s_waitcnt lgkmcnt(" #n ")" ::: "memory")
#define PG8_BAR __builtin_amdgcn_s_barrier()
#define PG8_SCHED __builtin_amdgcn_sched_barrier(0)
    Unit cur, nxt; int ui = 0;
    if (!S.next(0, cur)) return;
    f32x4 acc[2][2][4][2];
#pragma unroll
    for (int a = 0; a < 2; ++a)
#pragma unroll
        for (int b = 0; b < 2; ++b)
#pragma unroll
            for (int m = 0; m < 4; ++m)
#pragma unroll
                for (int n = 0; n < 2; ++n) acc[a][b][m][n] = (f32x4){0.f, 0.f, 0.f, 0.f};
    bf16x8 At[4][2], B0[2][2], B1[2][2];
    unsigned va[2][2];
    PG8_LAS u32x4* vslot = (PG8_LAS u32x4*)(lds + VN_SLOT_OFF) + tid;
    S.aoff(cur, Rp, Cp, va);
    const char* cA = cur.abase; const char* cB0 = cur.b0; const char* cB1 = cur.b1;
    PG8_STAGE(PG8_SB(0, 0), cB0, voffB); PG8_STAGE(PG8_SB(0, 1), cB1, voffB); PG8_STAGE(PG8_SA(0, 0), cA, va[0]); PG8_STAGE(PG8_SA(0, 1), cA, va[1]);
    if (wr == 1) PG8_BAR;
    PG8_WAIT_V(2); PG8_BAR;
    PG8_STAGE(PG8_SB(1, 0), cB0 + kstep, voffB); PG8_STAGE(PG8_SA(1, 0), cA + kstep, va[0]); PG8_STAGE(PG8_SB(1, 1), cB1 + kstep, voffB);
    PG8_WAIT_V(6); PG8_BAR;
    for (;;) {
        const bool has_next = S.next(ui + 1, nxt);
        if constexpr (Sched::GATHER) { unsigned vn[2][2]; if (has_next) S.aoff(nxt, Rp, Cp, vn); else { vn[0][0] = va[0][0]; vn[0][1] = va[0][1]; vn[1][0] = va[1][0]; vn[1][1] = va[1][1]; }
            *vslot = (u32x4){vn[0][0], vn[0][1], vn[1][0], vn[1][1]}; }
        const char* nA = has_next ? nxt.abase : cA; const char* nB0 = has_next ? nxt.b0 : cB0; const char* nB1 = has_next ? nxt.b1 : cB1;
        for (int t = 0; t < nt; t += 2) {
            const bool last = (t == nt - 2);
            const char* a1 = cA + (size_t)(t + 1) * kstep;
            const char* a2 = last ? nA : cA + (size_t)(t + 2) * kstep;
            const char* b20 = last ? nB0 : cB0 + (size_t)(t + 2) * kstep; const char* b21 = last ? nB1 : cB1 + (size_t)(t + 2) * kstep;
            const char* a3 = a2 + kstep; const char* b30 = b20 + kstep; const char* b31 = b21 + kstep;
            PG8_LDB(B0, 0, 0); PG8_LDB(B1, 0, 1); PG8_SCHED; PG8_LDA(At, 0, 0); PG8_STAGE(PG8_SA(1, 1), a1, va[1]);
            PG8_WAIT_V(8); PG8_WAIT_L(0); PG8_BAR; PG8_MMA(0, 0, At, B0); PG8_MMA(0, 1, At, B1); PG8_BAR; PG8_SCHED;
            if constexpr (Sched::GATHER) { if (last) { const u32x4 q = *vslot; va[0][0] = q[0]; va[0][1] = q[1]; va[1][0] = q[2]; va[1][1] = q[3]; } }
            PG8_LDA(At, 0, 1); PG8_STAGE(PG8_SB(0, 0), b20, voffB); PG8_STAGE(PG8_SB(0, 1), b21, voffB); PG8_STAGE(PG8_SA(0, 0), a2, va[0]);
            PG8_WAIT_V(8); PG8_WAIT_L(0); PG8_BAR; PG8_MMA(1, 0, At, B0); PG8_MMA(1, 1, At, B1); PG8_BAR; PG8_SCHED;
            PG8_LDB(B0, 1, 0); PG8_LDB(B1, 1, 1); PG8_SCHED; PG8_LDA(At, 1, 0); PG8_STAGE(PG8_SA(0, 1), a2, va[1]);
            PG8_WAIT_V(8); PG8_WAIT_L(0); PG8_BAR; PG8_MMA(0, 0, At, B0); PG8_MMA(0, 1, At, B1); PG8_BAR; PG8_SCHED;
            PG8_LDA(At, 1, 1); PG8_STAGE(PG8_SB(1, 0), b30, voffB); PG8_STAGE(PG8_SB(1, 1), b31, voffB); PG8_STAGE(PG8_SA(1, 0), a3, va[0]);
            PG8_WAIT_V(8); PG8_WAIT_L(0); PG8_BAR; PG8_MMA(1, 0, At, B0); PG8_MMA(1, 1, At, B1); PG8_BAR; PG8_SCHED;
        }
        if (wr == 0) PG8_BAR;
        E(acc, cur, wr, wc, fr, fq);
        if (!has_next) break;
#pragma unroll
        for (int a = 0; a < 2; ++a)
#pragma unroll
            for (int b = 0; b < 2; ++b)
#pragma unroll
                for (int m = 0; m < 4; ++m)
#pragma unroll
                    for (int n = 0; n < 2; ++n) acc[a][b][m][n] = (f32x4){0.f, 0.f, 0.f, 0.f};
        cur = nxt; cA = nA; cB0 = nB0; cB1 = nB1; ++ui;
        if (wr == 1) PG8_BAR;
    }
    PG8_WAIT_V(0);
    PG8_BAR;
#undef PG8_SA
#undef PG8_SB
#undef PG8_STAGE
#undef PG8_LDA
#undef PG8_LDB
#undef PG8_MMA
#undef PG8_WAIT_V
#undef PG8_WAIT_L
#undef PG8_BAR
#undef PG8_SCHED
}
}
namespace {
constexpr int D = 1024, NB = 8, SEQ = 2048, T = NB * SEQ, PW = 3584, SW = 512, NG = 32, NP = 64, NHC = 16;
constexpr int GW = 512, NHEAD = 8, HD = 64, CHUNK = 128, NCH = SEQ / CHUNK, NE = 32, TOPK = 4, DE = 1024, NMOD = 6;
constexpr int PADROWS = T * TOPK + NE * 256;
constexpr float EPS = 1e-6f;
constexpr int NWAVES = 8, NTHREADS = NWAVES * 64;
constexpr int MODK = 8;

#define GAS __attribute__((address_space(1)))
#define LAS __attribute__((address_space(3)))
typedef unsigned short bf16;
typedef unsigned v4u __attribute__((ext_vector_type(4)));
typedef unsigned v2u __attribute__((ext_vector_type(2)));
typedef int v4i __attribute__((ext_vector_type(4)));
typedef float f32x4 __attribute__((ext_vector_type(4)));
typedef float f32x2 __attribute__((ext_vector_type(2)));
typedef short bf16x8 __attribute__((ext_vector_type(8)));
typedef GAS unsigned gu32;
#define RLX_AGENT __ATOMIC_RELAXED, __HIP_MEMORY_SCOPE_AGENT
#define LDS_WAIT() asm volatile("s_waitcnt lgkmcnt(0)" ::: "memory")
#define VM_WAIT() asm volatile("s_waitcnt vmcnt(0)" ::: "memory")
__device__ __forceinline__ unsigned f2bf(float f) { unsigned u = __builtin_bit_cast(unsigned, f); return (u + 0x7fffu + ((u >> 16) & 1u)) >> 16; }
__device__ __forceinline__ unsigned pk2(float lo, float hi) { return f2bf(lo) | (f2bf(hi) << 16); }
__device__ __forceinline__ float bf2f(unsigned short b) { return __builtin_bit_cast(float, (unsigned)b << 16); }
__device__ __forceinline__ float bflo(unsigned w) { return __builtin_bit_cast(float, w << 16); }
__device__ __forceinline__ float bfhi(unsigned w) { return __builtin_bit_cast(float, w & 0xffff0000u); }
__device__ __forceinline__ float sigm(float x) { return __builtin_amdgcn_rcpf(1.f + __expf(-x)); }
__device__ __forceinline__ float gelu_t(float x) { const float u = 1.5957691216057308f * (x + 0.044715f * x * x * x); return x * sigm(u); }
__device__ __forceinline__ float wave_sum(float v) {
#pragma unroll
    for (int o = 1; o < 64; o <<= 1) v += __shfl_xor(v, o);
    return v;
}

constexpr size_t MiB = 1u << 20;
constexpr size_t WS_CTL = 0, CTL_ZERO_BYTES = 64 * 1024;
constexpr int CW_BAR = 1024;
constexpr size_t WS_MODP = 1 * MiB;
constexpr size_t WS_MOD = 3 * MiB;
constexpr size_t WS_WSM = 4 * MiB;
constexpr size_t WS_CMT = WS_WSM + 512 * 1024;
constexpr size_t WS_RWT = 5 * MiB;
constexpr size_t WS_ROUTE = 6 * MiB;
constexpr size_t WS_SEG = WS_ROUTE + 192 * 1024, WS_SROW = WS_ROUTE + 256 * 1024;
constexpr size_t WS_TOPI = 7 * MiB, WS_TOPW = WS_TOPI + 256 * 1024, WS_POS = WS_TOPW + 256 * 1024;
constexpr size_t WS_KERN = 8 * MiB;
constexpr size_t WS_LAMT = 10 * MiB;
constexpr size_t WS_E = 13 * MiB;
constexpr size_t WS_ME = 16 * MiB;
constexpr size_t WS_WINT = 32 * MiB;
constexpr size_t WS_GLUT = 40 * MiB;
constexpr size_t WS_WAT = 41 * MiB, WS_WBT = 42 * MiB;
constexpr size_t WS_WOT = 43 * MiB;
constexpr size_t WS_W1T = 48 * MiB;
constexpr size_t WS_W2T = 176 * MiB;
constexpr size_t WS_X1 = 240 * MiB;
constexpr size_t WS_H2 = 304 * MiB;
constexpr size_t WS_RX = 336 * MiB;
constexpr size_t WS_RY = 480 * MiB;
constexpr size_t WS_H1 = WS_RY, WS_Z = WS_RY + 32 * MiB, WS_GM = WS_RY + 48 * MiB, WS_OA = WS_RY + 64 * MiB, WS_MB = WS_RY + 80 * MiB, WS_MRG = WS_RY + 112 * MiB;
constexpr size_t WS_END = 624 * MiB;
static_assert((size_t)PADROWS * 1024 * 2 <= 144 * MiB, "act / ys fit their regions");

constexpr int RING_BYTES = 131072;
constexpr int LDSCTL_OFF = RING_BYTES, MISC_OFF = LDSCTL_OFF + 320;
constexpr int LDS_BYTES = 147456;

#define XB_TMO      128
#define XB_XCNT(j)  (256  + 64 * (j))
#define XB_XSUB(j)  (1280 + 64 * (j))
#define XB_XGEN(j)  (2304 + 64 * (j))
#define XB_TOP      3328
#define XB_TOPGEN   3392
#define XCD_BAR_WORDS 3456
#define XB_SPIN_CAP (1u << 18)
__device__ __forceinline__ unsigned xb_ld(unsigned* p)              { return __hip_atomic_load(p, __ATOMIC_RELAXED, __HIP_MEMORY_SCOPE_AGENT); }
__device__ __forceinline__ unsigned xb_add(unsigned* p, unsigned v) { return __hip_atomic_fetch_add(p, v, __ATOMIC_RELAXED, __HIP_MEMORY_SCOPE_AGENT); }
__device__ __forceinline__ unsigned xb_xcc_id() { return (unsigned)__builtin_amdgcn_s_getreg((3 << 11) | 20) & 0xFu; }
#define XB_SPIN(cond, bar) do { unsigned _sp = 0; while (cond) { __builtin_amdgcn_s_sleep(1); \
    if ((++_sp & 255u) == 0u) { if (xb_ld(&(bar)[XB_TMO])) break; if (_sp > XB_SPIN_CAP) { atomicAdd(&(bar)[XB_TMO], 1u); break; } } } } while (0)
struct XcdBarrier { unsigned* bar; unsigned x; volatile LAS unsigned* st; };
__device__ __forceinline__ XcdBarrier xcd_barrier_post(unsigned* bar, volatile LAS unsigned* st) {
    XcdBarrier b; b.bar = bar; b.x = xb_xcc_id(); b.st = st;
    if (threadIdx.x == 0) (void)xb_add(&bar[XB_XCNT(b.x)], 1u);
    return b;
}
__device__ __forceinline__ void xcd_barrier_complete(unsigned* bar, unsigned x, unsigned& nloc, unsigned& nx) {
    const unsigned G = gridDim.x * gridDim.y * gridDim.z;
    unsigned sum, cnt, mine, sp = 0u;
    for (;;) {
        sum = 0u; cnt = 0u; mine = 0u;
#pragma unroll
        for (unsigned j = 0; j < 16; ++j) { const unsigned c = xb_ld(&bar[XB_XCNT(j)]); sum += c; cnt += (c > 0u) ? 1u : 0u; mine = (j == x) ? c : mine; }
        if (sum == G) break;
        __builtin_amdgcn_s_sleep(1);
        if ((++sp & 255u) == 0u) { if (xb_ld(&bar[XB_TMO])) break; if (sp > XB_SPIN_CAP) { atomicAdd(&bar[XB_TMO], 1u); break; } }
    }
    nloc = mine > 0u ? mine : 1u; nx = cnt > 0u ? cnt : 1u;
}
__device__ __forceinline__ void xcd_barrier(const XcdBarrier& b) {
    asm volatile("s_waitcnt vmcnt(0)" ::: "memory");
    __syncthreads();
    if (threadIdx.x == 0) {
        unsigned* bar = b.bar;
        __builtin_amdgcn_s_waitcnt(0);
        unsigned nloc = b.st[0], nx = b.st[1];
        if (nloc == 0u) { xcd_barrier_complete(bar, b.x, nloc, nx); b.st[0] = nloc; b.st[1] = nx; }
        const unsigned old = xb_add(&bar[XB_XSUB(b.x)], 1u);
        const unsigned gen = old / nloc;
        if (old + 1u == (gen + 1u) * nloc) {
            __builtin_amdgcn_fence(__ATOMIC_RELEASE, "agent");
            asm volatile("s_waitcnt vmcnt(0)" ::: "memory");
            const unsigned og = xb_add(&bar[XB_TOP], 1u);
            const unsigned tg = og / nx;
            if (og + 1u == (tg + 1u) * nx) xb_add(&bar[XB_TOPGEN], 1u);
            else XB_SPIN(xb_ld(&bar[XB_TOPGEN]) == tg, bar);
            __builtin_amdgcn_fence(__ATOMIC_ACQUIRE, "agent");
            xb_add(&bar[XB_XGEN(b.x)], 1u);
            asm volatile("s_waitcnt vmcnt(0)" ::: "memory");
        } else {
            XB_SPIN(xb_ld(&bar[XB_XGEN(b.x)]) == gen, bar);
            __builtin_amdgcn_fence(__ATOMIC_ACQUIRE, "agent");
            asm volatile("s_waitcnt vmcnt(0)" ::: "memory");
        }
    }
    __syncthreads();
}

struct Args { const float* in[31]; float* out; unsigned char* ws; int ph_lo, ph_hi, rep, pad; };
struct Frame {
    LAS unsigned char* lds;
    int wave, vcu, G;
};
struct DenseOrder {
    const char* A; const char* Bt; int K, nM, nN, nwg, G, c;
    __device__ __forceinline__ void init(const void* A_, const void* Bt_, int M, int N, int K_, int G_, int c_) { A = (const char*)A_; Bt = (const char*)Bt_; K = K_; nM = M / 256; nN = N / 256; nwg = nM * nN; G = G_; c = c_; }
    __device__ __forceinline__ bool next(int i, pg8::Unit& u) const {
        const long L = (long)i * G + c; if (L >= nwg) return false;
        int wgid = (int)L; { const int q = nwg / 8, r = nwg % 8, xcd = wgid % 8, off = wgid / 8; wgid = (xcd < r ? xcd * (q + 1) : r * (q + 1) + (xcd - r) * q) + off; }
        const int nig = 8 * nN, gid = wgid / nig, fm = gid * 8, gsz = (nM - fm) < 8 ? (nM - fm) : 8;
        u.pm = fm + ((wgid % nig) % gsz); u.pn = (wgid % nig) / gsz; u.aux = 0;
        u.abase = A + (size_t)u.pm * 256 * K * 2; u.b0 = Bt + (size_t)u.pn * 256 * K * 2; u.b1 = u.b0 + (size_t)128 * K * 2; return true;
    }
    static constexpr bool GATHER = false;
    __device__ __forceinline__ void aoff(const pg8::Unit&, const int (&R)[2], const int (&C)[2], unsigned (&va)[2][2]) const {
#pragma unroll
        for (int h = 0; h < 2; ++h)
#pragma unroll
            for (int i = 0; i < 2; ++i) va[h][i] = (unsigned)((h * 128 + R[i]) * K + C[i]) * 2u;
    }
};

__device__ __forceinline__ void p0_transpose_item(const float* W, int K, int N, bf16* WT, LAS float* scr, int item, int lane) {
    const int nblk = N / 32, kb = item / nblk, nb = item % nblk, k0 = 64 * kb, n0 = 32 * nb;
    float wv[32];
#pragma unroll
    for (int i = 0; i < 32; ++i) wv[i] = W[(size_t)(k0 + 2 * i + (lane >> 5)) * N + n0 + (lane & 31)];
#pragma unroll
    for (int i = 0; i < 32; ++i) scr[(2 * i + (lane >> 5)) * 33 + (lane & 31)] = wv[i];
    LDS_WAIT(); asm volatile("" ::: "memory");
    const int c = lane & 7;
#pragma unroll
    for (int j = 0; j < 4; ++j) { const int n = (lane >> 3) + 8 * j; const LAS float* s = scr + (8 * c) * 33 + n;
        v4u o; o.x = pk2(s[0 * 33], s[1 * 33]); o.y = pk2(s[2 * 33], s[3 * 33]); o.z = pk2(s[4 * 33], s[5 * 33]); o.w = pk2(s[6 * 33], s[7 * 33]);
        *(GAS v4u*)(WT + (size_t)(n0 + n) * K + k0 + 8 * c) = o; }
    LDS_WAIT(); asm volatile("" ::: "memory");
}
__device__ __forceinline__ void p0_s5_item(const Args& A, unsigned char* ws, LAS float* scr, int item, int lane) {
    const int g = item / 129, tau = item % 129, p = lane;
    const float* a_re = A.in[6]; const float* a_im = A.in[7]; const float* log_dt = A.in[8]; const float* b_re = A.in[9]; const float* b_im = A.in[10]; const float* c_re = A.in[11]; const float* c_im = A.in[12];
    if (tau < 128) {
#pragma unroll
        for (int i = 0; i < 4; ++i) { *(LAS f32x4*)(scr + 2048 + (lane + 64 * i) * 4) = ((const GAS f32x4*)(c_re + (size_t)g * NHC * NP))[lane + 64 * i]; *(LAS f32x4*)(scr + 3072 + (lane + 64 * i) * 4) = ((const GAS f32x4*)(c_im + (size_t)g * NHC * NP))[lane + 64 * i]; }
    }
    const double dt = exp((double)log_dt[g]);
    const double lr = a_re[g * NP + p], li = a_im[g * NP + p];
    const double mg = exp(lr * dt * (double)tau), an = li * dt * (double)tau;
    const float ltr = (float)(mg * cos(an)), lti = (float)(mg * sin(an));
    ((GAS f32x2*)(ws + WS_LAMT))[(size_t)(g * 129 + tau) * NP + p] = (f32x2){ltr, lti};
    if (tau == 128) return;
    const double m1 = exp(lr * dt), lbr = m1 * cos(li * dt), lbi = m1 * sin(li * dt);
    const double nr = lbr - 1.0, ni = lbi, den = lr * lr + li * li;
    const float cfr = (float)((nr * lr + ni * li) / den), cfi = (float)((ni * lr - nr * li) / den);
    const float wr_ = ltr * cfr - lti * cfi, wi_ = ltr * cfi + lti * cfr;
    const f32x4* brp = (const f32x4*)(b_re + (size_t)(g * NP + p) * NHC); const f32x4* bip = (const f32x4*)(b_im + (size_t)(g * NP + p) * NHC);
    unsigned mre[8], mim[8];
#pragma unroll
    for (int q = 0; q < 4; ++q) { const f32x4 br = brp[q], bi = bip[q]; float vr[4], vi[4];
#pragma unroll
        for (int j = 0; j < 4; ++j) { vr[j] = wr_ * br[j] - wi_ * bi[j]; vi[j] = wr_ * bi[j] + wi_ * br[j]; scr[(p * 16 + q * 4 + j) * 2] = vr[j]; scr[(p * 16 + q * 4 + j) * 2 + 1] = vi[j]; }
        mre[2 * q] = pk2(vr[0], vr[1]); mre[2 * q + 1] = pk2(vr[2], vr[3]); mim[2 * q] = pk2(vi[0], vi[1]); mim[2 * q + 1] = pk2(vi[2], vi[3]); }
    { GAS v4u* o = (GAS v4u*)((bf16*)(ws + WS_ME) + ((size_t)(g * 128 + 2 * p) * 2048 + (127 - tau) * 16));
      o[0] = (v4u){mre[0], mre[1], mre[2], mre[3]}; o[1] = (v4u){mre[4], mre[5], mre[6], mre[7]};
      GAS v4u* o2 = (GAS v4u*)((bf16*)(ws + WS_ME) + ((size_t)(g * 128 + 2 * p + 1) * 2048 + (127 - tau) * 16));
      o2[0] = (v4u){mim[0], mim[1], mim[2], mim[3]}; o2[1] = (v4u){mim[4], mim[5], mim[6], mim[7]}; }
    LDS_WAIT(); asm volatile("" ::: "memory");
    const int ho = lane >> 2, hi0 = 4 * (lane & 3);
    const LAS float* crp = scr + 2048 + ho * NP; const LAS float* cip = scr + 3072 + ho * NP;
    float kk[4] = {0.f, 0.f, 0.f, 0.f};
#pragma unroll 8
    for (int pp = 0; pp < NP; ++pp) { const float cr = crp[pp], ci = cip[pp];
#pragma unroll
        for (int j = 0; j < 4; ++j) { const f32x2 w = *(const LAS f32x2*)(scr + (pp * 16 + hi0 + j) * 2); kk[j] += cr * w.x - ci * w.y; } }
    *(GAS v2u*)((bf16*)(ws + WS_KERN) + ((size_t)(g * 128 + tau) * 256 + ho * 16 + hi0)) = (v2u){pk2(kk[0], kk[1]), pk2(kk[2], kk[3])};
    LDS_WAIT(); asm volatile("" ::: "memory");
}
__device__ __forceinline__ void p0_mod_block_item(const Args& A, unsigned char* ws, LAS unsigned char* lds, int wave, int item) {
    const float* c = A.in[1]; const float* ada_w = A.in[2]; const float* ada_b = A.in[3];
    const int lane = (int)threadIdx.x & 63, j = item * 64 + lane;
    LAS float* scr = (LAS float*)(lds + wave * 16384);
    for (int i = lane; i < 8 * 128; i += 64) { const int b = i >> 7, k = i & 127; const float cv = c[b * D + wave * 128 + k]; scr[k * 8 + b] = cv / (1.f + __expf(-cv)); }
    LDS_WAIT(); asm volatile("" ::: "memory");
    float acc[8] = {0.f, 0.f, 0.f, 0.f, 0.f, 0.f, 0.f, 0.f};
    const float* wp = ada_w + (size_t)(wave * 128) * (NMOD * D) + j;
#pragma unroll 1
    for (int k0 = 0; k0 < 128; k0 += 16) { float wv[16];
#pragma unroll
        for (int q = 0; q < 16; ++q) wv[q] = wp[(size_t)(k0 + q) * (NMOD * D)];
#pragma unroll
        for (int q = 0; q < 16; ++q) { const f32x4 s0 = *(const LAS f32x4*)(scr + (k0 + q) * 8), s1 = *(const LAS f32x4*)(scr + (k0 + q) * 8 + 4);
            acc[0] += s0[0] * wv[q]; acc[1] += s0[1] * wv[q]; acc[2] += s0[2] * wv[q]; acc[3] += s0[3] * wv[q]; acc[4] += s1[0] * wv[q]; acc[5] += s1[1] * wv[q]; acc[6] += s1[2] * wv[q]; acc[7] += s1[3] * wv[q]; } }
    LDS_WAIT(); __syncthreads();
    LAS float* red = (LAS float*)lds;
#pragma unroll
    for (int b = 0; b < 8; ++b) red[(wave * 8 + b) * 64 + lane] = acc[b];
    LDS_WAIT(); __syncthreads();
    { float v = ada_b[j];
#pragma unroll
      for (int w2 = 0; w2 < 8; ++w2) v += red[(w2 * 8 + wave) * 64 + lane];
      ((float*)(ws + WS_MOD))[wave * (NMOD * D) + j] = v; }
    LDS_WAIT(); __syncthreads();
}
__device__ __forceinline__ void p0_prologue(const Args& A, const Frame& F) {
    unsigned char* ws = A.ws;
    LAS float* scr = (LAS float*)(F.lds + F.wave * 16384);
    const int gw = F.vcu * NWAVES + F.wave, NGW = F.G * NWAVES;
    constexpr int I_S5 = NG * 129, I_MOD = NMOD * D / 64;
    constexpr int I_WIN = (D / 64) * (PW / 32), I_GLU = (SW / 64) * (SW / 32), I_BR = (SW / 64) * (D / 32), I_WO = (D / 64) * (D / 32), I_M1 = (D / 64) * (2 * DE / 32), I_M2 = (DE / 64) * (D / 32);
    constexpr int NITEMS = I_S5 + I_WIN + I_GLU + 2 * I_BR + I_WO + NE * I_M1 + NE * I_M2;
    for (int it = F.vcu; it < I_MOD; it += F.G) p0_mod_block_item(A, ws, F.lds, F.wave, it);
    for (int it = gw; it < NITEMS; it += NGW) {
        int r = it;
        if (r < I_S5) { p0_s5_item(A, ws, scr, r, ((int)threadIdx.x & 63)); continue; } r -= I_S5;
        if (r < I_WIN) { p0_transpose_item(A.in[5], D, PW, (bf16*)(ws + WS_WINT), scr, r, ((int)threadIdx.x & 63)); continue; } r -= I_WIN;
        if (r < I_GLU) { p0_transpose_item(A.in[14], SW, SW, (bf16*)(ws + WS_GLUT), scr, r, ((int)threadIdx.x & 63)); continue; } r -= I_GLU;
        if (r < I_BR) { p0_transpose_item(A.in[16], SW, D, (bf16*)(ws + WS_WAT), scr, r, ((int)threadIdx.x & 63)); continue; } r -= I_BR;
        if (r < I_BR) { p0_transpose_item(A.in[21], SW, D, (bf16*)(ws + WS_WBT), scr, r, ((int)threadIdx.x & 63)); continue; } r -= I_BR;
        if (r < I_WO) { p0_transpose_item(A.in[22], D, D, (bf16*)(ws + WS_WOT), scr, r, ((int)threadIdx.x & 63)); continue; } r -= I_WO;
        if (r < NE * I_M1) { const int e = r / I_M1; p0_transpose_item(A.in[26] + (size_t)e * D * 2 * DE, D, 2 * DE, (bf16*)(ws + WS_W1T) + (size_t)e * 2 * DE * D, scr, r % I_M1, ((int)threadIdx.x & 63)); continue; } r -= NE * I_M1;
        { const int e = r / I_M2; p0_transpose_item(A.in[28] + (size_t)e * DE * D, DE, D, (bf16*)(ws + WS_W2T) + (size_t)e * D * DE, scr, r % I_M2, ((int)threadIdx.x & 63)); }
    }
    const int gt = F.vcu * NTHREADS + ((int)threadIdx.x), NGT = F.G * NTHREADS;
    for (int i = gt; i < NG * NHC * 128; i += NGT) { const int k = i & 127, ho = (i >> 7) & 15, g = i >> 11, p = k >> 1;
        const float v = (k & 1) ? -A.in[12][(size_t)(g * NHC + ho) * NP + p] : A.in[11][(size_t)(g * NHC + ho) * NP + p]; ((bf16*)(ws + WS_CMT))[i] = (bf16)f2bf(v); }
    for (int i = gt; i < NHEAD * CHUNK * CHUNK; i += NGT) { const int s = i & 127, t = (i >> 7) & 127; ((bf16*)(ws + WS_WSM))[i] = (s <= t) ? (bf16)f2bf(A.in[19][i]) : (bf16)0; }
    for (int i = gt; i < D * NE; i += NGT) { const int e = i & 31, k = i >> 5; const float v = A.in[24][i]; const unsigned hi = f2bf(v); const float lo = v - bf2f((unsigned short)hi);
        ((bf16*)(ws + WS_RWT))[e * D + k] = (bf16)hi; ((bf16*)(ws + WS_RWT))[NE * D + e * D + k] = (bf16)f2bf(lo); }
}

__device__ __forceinline__ void norm_mod_row_bf16(const float* xrow, const float* g, const float* shift, const float* scale, bf16* orow, int lane) {
    const GAS f32x4* xr = (const GAS f32x4*)xrow + lane;
    f32x4 v[4]; float s = 0.f;
#pragma unroll
    for (int j = 0; j < 4; ++j) { v[j] = xr[64 * j]; s += (v[j].x * v[j].x + v[j].y * v[j].y) + (v[j].z * v[j].z + v[j].w * v[j].w); }
    const float r = rsqrtf(wave_sum(s) * (1.f / D) + EPS);
    GAS v2u* o8 = (GAS v2u*)orow + lane;
#pragma unroll
    for (int j = 0; j < 4; ++j) { const f32x4 gg = ((const GAS f32x4*)g)[lane + 64 * j], sh = ((const GAS f32x4*)shift)[lane + 64 * j], sc = ((const GAS f32x4*)scale)[lane + 64 * j];
        const f32x4 o = v[j] * r * gg * (sc + 1.f) + sh; o8[64 * j] = (v2u){pk2(o.x, o.y), pk2(o.z, o.w)}; }
}
__device__ __forceinline__ void p1_h1(const Args& A, const Frame& F) {
    const int gw = F.vcu * NWAVES + F.wave, NGW = F.G * NWAVES;
    const float* mod = (const float*)(A.ws + WS_MOD);
    for (int m = gw; m < T; m += NGW) { const int b = m / SEQ;
        norm_mod_row_bf16(A.in[0] + (size_t)m * D, A.in[4], mod + b * (NMOD * D), mod + b * (NMOD * D) + D, (bf16*)(A.ws + WS_H1) + (size_t)m * D, ((int)threadIdx.x & 63)); }
}

struct EpiProj {
    static constexpr bool PERM = true;
    bf16* O;
    __device__ __forceinline__ void operator()(const pg8::f32x4 (&acc)[2][2][4][2], const pg8::Unit& u, int wr, int wc, int fr, int fq) const {
        const int row0 = u.pm * 256 + wr * 64 + fr, col0 = u.pn * 256 + wc * 32 + 8 * fq;
        const int mode = u.pn < 2 ? 0 : (u.pn < 6 ? 1 : 2);
#pragma unroll
        for (int ai = 0; ai < 2; ++ai)
#pragma unroll
            for (int m = 0; m < 4; ++m) { bf16* rowp = O + (size_t)(row0 + ai * 128 + m * 16) * PW + col0;
#pragma unroll
                for (int bj = 0; bj < 2; ++bj) { float v[8];
#pragma unroll
                    for (int j = 0; j < 4; ++j) { v[j] = acc[ai][bj][m][0][j]; v[4 + j] = acc[ai][bj][m][1][j]; }
                    if (mode == 1) {
#pragma unroll
                        for (int j = 0; j < 8; ++j) v[j] = gelu_t(v[j]); }
                    else if (mode == 2) {
#pragma unroll
                        for (int j = 0; j < 8; ++j) v[j] = sigm(v[j]); }
                    *(v4u*)(rowp + bj * 128) = (v4u){pk2(v[0], v[1]), pk2(v[2], v[3]), pk2(v[4], v[5]), pk2(v[6], v[7])}; } }
    }
};
__device__ __forceinline__ void p2_proj(const Args& A, const Frame& F) {
    DenseOrder S; S.init(A.ws + WS_H1, A.ws + WS_WINT, T, PW, D, F.G, (int)blockIdx.x);
    EpiProj E{(bf16*)(A.ws + WS_RX)};
    pg8::gemm_phase<EpiProj, DenseOrder>(F.lds, D, S, E);
}
__device__ __forceinline__ void p3_epass_unit(const Args& A, const Frame& F, int unit) {
    const int b = unit >> 5, g = unit & 31, tid = (int)threadIdx.x, lane = tid & 63, m = lane & 15, kq = lane >> 4;
    const bf16* PA = (const bf16*)(A.ws + WS_RX);
#pragma unroll
    for (int i = 0; i < 8; ++i) { const int id = tid + 512 * i, tok = id >> 1, half = id & 1;
        *(LAS v4u*)(F.lds + (tok >> 7) * 4112 + (tok & 127) * 32 + half * 16) = *(const GAS v4u*)(PA + (size_t)(b * SEQ + tok) * PW + g * NHC + 8 * half); }
    LDS_WAIT(); __syncthreads();
    const LAS unsigned char* ua = F.lds + m * 4112 + (kq >> 1) * 32 + (kq & 1) * 16;
    const bf16* mb = (const bf16*)(A.ws + WS_ME) + ((size_t)(g * 128 + F.wave * 16 + m) * 2048 + 8 * kq);
    f32x4 acc = {0.f, 0.f, 0.f, 0.f};
#pragma unroll 1
    for (int k0 = 0; k0 < 64; k0 += 16) {
        bf16x8 bfr[16];
#pragma unroll
        for (int j = 0; j < 16; ++j) bfr[j] = *(const GAS bf16x8*)(mb + 32 * (k0 + j));
#pragma unroll
        for (int j = 0; j < 16; ++j) { const bf16x8 af = *(const LAS bf16x8*)(ua + (k0 + j) * 64); acc = __builtin_amdgcn_mfma_f32_16x16x32_bf16(bfr[j], af, acc, 0, 0, 0); }
    }
    *(GAS f32x4*)((float*)(A.ws + WS_E) + ((size_t)((b * NCH + m) * NG + g) * 128 + F.wave * 16 + 4 * kq)) = acc;
    __syncthreads();
}

constexpr int VNT_STRIDE = 272;
__device__ __forceinline__ void p3_gmlp_unit(const Args& A, const Frame& F, int unit) {
    const int chunk = unit >> 1, hh = unit & 1, lane = ((int)threadIdx.x & 63), w = F.wave;
    const bf16* PA = (const bf16*)(A.ws + WS_RX);
    const float* lng = A.in[17]; const float* lnb = A.in[18];
    const f32x4 g0 = *(const GAS f32x4*)(lng + 8 * lane), g1 = *(const GAS f32x4*)(lng + 8 * lane + 4), b0 = *(const GAS f32x4*)(lnb + 8 * lane), b1 = *(const GAS f32x4*)(lnb + 8 * lane + 4);
#pragma unroll 4
    for (int i = 0; i < 16; ++i) {
        const int s = 16 * w + i;
        const v4u raw = *(const GAS v4u*)(PA + (size_t)(chunk * CHUNK + s) * PW + 2 * GW + 8 * lane);
        float v[8] = {bflo(raw.x), bfhi(raw.x), bflo(raw.y), bfhi(raw.y), bflo(raw.z), bfhi(raw.z), bflo(raw.w), bfhi(raw.w)};
        float sm = 0.f, sq = 0.f;
#pragma unroll
        for (int j = 0; j < 8; ++j) { sm += v[j]; sq += v[j] * v[j]; }
#pragma unroll
        for (int o = 1; o < 64; o <<= 1) { sm += __shfl_xor(sm, o); sq += __shfl_xor(sq, o); }
        const float mu = sm * (1.f / GW);
        const float r = rsqrtf(fmaxf(sq * (1.f / GW) - mu * mu, 0.f) + EPS);
#pragma unroll
        for (int j = 0; j < 8; ++j) v[j] -= mu;
        if ((lane >> 5) == hh) {
            LAS unsigned char* dst = F.lds + (8 * (lane & 31)) * VNT_STRIDE + 2 * s;
#pragma unroll
            for (int j = 0; j < 8; ++j) { const float o = v[j] * r * (j < 4 ? g0[j & 3] : g1[j & 3]) + (j < 4 ? b0[j & 3] : b1[j & 3]); *(LAS unsigned short*)(dst + j * VNT_STRIDE) = (unsigned short)f2bf(o); }
        }
    }
    LDS_WAIT(); __syncthreads();
    const int hl = w >> 1, th = w & 1, h = 4 * hh + hl, fr = lane & 15, kq = lane >> 4;
    const bf16* wsm = (const bf16*)(A.ws + WS_WSM) + (size_t)h * CHUNK * CHUNK;
    f32x4 acc[4][4];
#pragma unroll
    for (int cb = 0; cb < 4; ++cb)
#pragma unroll
        for (int tb = 0; tb < 4; ++tb) acc[cb][tb] = (f32x4){0.f, 0.f, 0.f, 0.f};
    const int kmax = th ? 4 : 2;
    for (int kk = 0; kk < kmax; ++kk) {
        bf16x8 vf[4], wf[4];
#pragma unroll
        for (int cb = 0; cb < 4; ++cb) vf[cb] = *(const LAS bf16x8*)(F.lds + (64 * hl + 16 * cb + fr) * VNT_STRIDE + (32 * kk + 8 * kq) * 2);
#pragma unroll
        for (int tb = 0; tb < 4; ++tb) wf[tb] = *(const GAS bf16x8*)(wsm + (size_t)(64 * th + 16 * tb + fr) * CHUNK + 32 * kk + 8 * kq);
#pragma unroll
        for (int cb = 0; cb < 4; ++cb)
#pragma unroll
            for (int tb = 0; tb < 4; ++tb) acc[cb][tb] = __builtin_amdgcn_mfma_f32_16x16x32_bf16(vf[cb], wf[tb], acc[cb][tb], 0, 0, 0);
    }
    const float* bs = A.in[20] + h * CHUNK;
    bf16* GM = (bf16*)(A.ws + WS_GM);
#pragma unroll
    for (int tb = 0; tb < 4; ++tb) { const int t = 64 * th + 16 * tb + fr; const float bias = bs[t]; const size_t row = (size_t)(chunk * CHUNK + t);
#pragma unroll
        for (int cb = 0; cb < 4; ++cb) { const int cg = 256 * hh + 64 * hl + 16 * cb + 4 * kq;
            const v2u gu = *(const GAS v2u*)(PA + row * PW + GW + cg);
            const float o0 = bflo(gu.x) * (acc[cb][tb][0] + bias), o1 = bfhi(gu.x) * (acc[cb][tb][1] + bias), o2 = bflo(gu.y) * (acc[cb][tb][2] + bias), o3 = bfhi(gu.y) * (acc[cb][tb][3] + bias);
            *(GAS v2u*)(GM + row * GW + cg) = (v2u){pk2(o0, o1), pk2(o2, o3)}; } }
    __syncthreads();
}
__device__ __forceinline__ void p3_phase(const Args& A, const Frame& F) {
    for (int u = F.vcu; u < NB * NG + 2 * (T / CHUNK); u += F.G) { if (u < NB * NG) p3_epass_unit(A, F, u); else p3_gmlp_unit(A, F, u - NB * NG); }
}

constexpr int Y_KERN = 0, Y_UT = 65536, Y_UTW = 4608, Y_CMT = Y_UT + 8 * Y_UTW, Y_CMT_STRIDE = 272, Y_XS = Y_CMT + 16 * Y_CMT_STRIDE, Y_END = Y_XS + 8 * 512;
static_assert(Y_END <= RING_BYTES, "Y-pass LDS map");
__device__ __forceinline__ void p4_ypass_unit(const Args& A, const Frame& F, int unit) {
    int lane = ((int)threadIdx.x & 63), tid = ((int)threadIdx.x); asm volatile("" : "+v"(lane), "+v"(tid));
    const int g = unit >> 4, o = unit & 15, w = F.wave, gc = 8 * o + w, b = gc >> 4, c = gc & 15;
    int fr = lane & 15, kq = lane >> 4;
    const bf16* PA = (const bf16*)(A.ws + WS_RX);
    LAS unsigned char* lds = F.lds;
    { const GAS v4u* src = (const GAS v4u*)(A.ws + WS_KERN + (size_t)g * 65536);
#pragma unroll
      for (int i = 0; i < 8; ++i) *(LAS v4u*)(lds + Y_KERN + (tid + 512 * i) * 16) = src[tid + 512 * i]; }
    if (tid < 256) { const int ho = tid >> 4, ch = tid & 15; *(LAS v4u*)(lds + Y_CMT + ho * Y_CMT_STRIDE + ch * 16) = *(const GAS v4u*)(A.ws + WS_CMT + (size_t)(g * NHC + ho) * 256 + ch * 16); }
    LAS unsigned char* ut = lds + Y_UT + w * Y_UTW;
#pragma unroll
    for (int i = 0; i < 4; ++i) { const int id = lane + 64 * i, s = id >> 1, half = id & 1;
        *(LAS v4u*)(ut + half * 2304 + (16 + s) * 16) = *(const GAS v4u*)(PA + (size_t)(gc * CHUNK + s) * PW + g * NHC + 8 * half); }
    if (lane < 32) *(LAS v4u*)(ut + (lane >> 4) * 2304 + (lane & 15) * 16) = (v4u){0u, 0u, 0u, 0u};
    { const f32x2 l128 = ((const GAS f32x2*)(A.ws + WS_LAMT))[(size_t)(g * 129 + 128) * NP + lane];
      const GAS f32x2* ep = (const GAS f32x2*)((const float*)(A.ws + WS_E) + ((size_t)(b * NCH) * NG + g) * 128) + lane;
      float xr = 0.f, xi = 0.f;
      for (int cp = 0; cp < c; ++cp) { const f32x2 e = ep[(size_t)cp * NG * 64]; const float nr = l128.x * xr - l128.y * xi + e.x, ni = l128.x * xi + l128.y * xr + e.y; xr = nr; xi = ni; }
      *(LAS f32x2*)(lds + Y_XS + w * 512 + lane * 8) = (f32x2){xr, xi}; }
    LDS_WAIT(); __syncthreads();
    asm volatile("" : "+v"(lane)); fr = lane & 15; kq = lane >> 4;
    f32x4 acc[8];
#pragma unroll
    for (int i = 0; i < 8; ++i) acc[i] = (f32x4){0.f, 0.f, 0.f, 0.f};
    const LAS unsigned char* kbase = lds + Y_KERN + (kq >> 1) * 512 + fr * 32 + (kq & 1) * 16;
    const LAS unsigned char* ubase = ut + (kq & 1) * 2304 + (16 + fr - (kq >> 1)) * 16;
#define Y_LD6(F, q_) do { F[0] = *(const LAS bf16x8*)(kbase + (q_) * 1024); F[1] = *(const LAS bf16x8*)(kbase + (q_) * 1024 + 1024); \
        F[2] = *(const LAS bf16x8*)(ub0 - (q_) * 32); F[3] = *(const LAS bf16x8*)(ub0 - (q_) * 32 - 32); F[4] = *(const LAS bf16x8*)(ub0 + 256 - (q_) * 32); F[5] = *(const LAS bf16x8*)(ub0 + 256 - (q_) * 32 - 32); } while (0)
#define Y_MM4(F, a0, a1) do { a0 = __builtin_amdgcn_mfma_f32_16x16x32_bf16(F[0], F[2], a0, 0, 0, 0); a1 = __builtin_amdgcn_mfma_f32_16x16x32_bf16(F[0], F[4], a1, 0, 0, 0); \
        a0 = __builtin_amdgcn_mfma_f32_16x16x32_bf16(F[1], F[3], a0, 0, 0, 0); a1 = __builtin_amdgcn_mfma_f32_16x16x32_bf16(F[1], F[5], a1, 0, 0, 0); } while (0)
#define Y_MM2(F, a1) do { a1 = __builtin_amdgcn_mfma_f32_16x16x32_bf16(F[0], F[4], a1, 0, 0, 0); a1 = __builtin_amdgcn_mfma_f32_16x16x32_bf16(F[1], F[5], a1, 0, 0, 0); } while (0)
#pragma unroll
    for (int j = 0; j < 4; ++j) {
        const LAS unsigned char* ub0 = ubase + (32 * j) * 16;
        bf16x8 fa[6], fb[6];
        const int qA = 16 * j + 8;
        Y_LD6(fa, 0);
#pragma unroll 1
        for (int q = 0; q < qA; q += 4) { Y_LD6(fb, q + 2); Y_MM4(fa, acc[2 * j], acc[2 * j + 1]); Y_LD6(fa, q + 4); Y_MM4(fb, acc[2 * j], acc[2 * j + 1]); }
#pragma unroll 1
        for (int q = qA; q < qA + 8; q += 4) { Y_LD6(fb, q + 2); Y_MM2(fa, acc[2 * j + 1]); Y_LD6(fa, q + 4); Y_MM2(fb, acc[2 * j + 1]); }
    }
#undef Y_LD6
#undef Y_MM4
#undef Y_MM2
    asm volatile("" : "+v"(lane)); fr = lane & 15; kq = lane >> 4;
    {
        bf16x8 cf[4]; float z[4][8], l16[4][8];
#pragma unroll
        for (int kk = 0; kk < 4; ++kk) {
            cf[kk] = *(const LAS bf16x8*)(lds + Y_CMT + fr * Y_CMT_STRIDE + (32 * kk + 8 * kq) * 2);
            const f32x4 x0 = *(const LAS f32x4*)(lds + Y_XS + w * 512 + (16 * kk + 4 * kq) * 8), x1 = *(const LAS f32x4*)(lds + Y_XS + w * 512 + (16 * kk + 4 * kq) * 8 + 16);
            const GAS f32x4* lp = (const GAS f32x4*)((const float*)(A.ws + WS_LAMT) + ((size_t)(g * 129 + fr + 1) * NP + 16 * kk + 4 * kq) * 2);
            const GAS f32x4* lq = (const GAS f32x4*)((const float*)(A.ws + WS_LAMT) + ((size_t)(g * 129 + 16) * NP + 16 * kk + 4 * kq) * 2);
            const f32x4 l0 = lp[0], l1 = lp[1], q0 = lq[0], q1 = lq[1];
            z[kk][0] = l0[0] * x0[0] - l0[1] * x0[1]; z[kk][1] = l0[0] * x0[1] + l0[1] * x0[0]; z[kk][2] = l0[2] * x0[2] - l0[3] * x0[3]; z[kk][3] = l0[2] * x0[3] + l0[3] * x0[2];
            z[kk][4] = l1[0] * x1[0] - l1[1] * x1[1]; z[kk][5] = l1[0] * x1[1] + l1[1] * x1[0]; z[kk][6] = l1[2] * x1[2] - l1[3] * x1[3]; z[kk][7] = l1[2] * x1[3] + l1[3] * x1[2];
#pragma unroll
            for (int j = 0; j < 4; ++j) { l16[kk][j] = q0[j]; l16[kk][4 + j] = q1[j]; }
        }
#pragma unroll
        for (int i = 0; i < 8; ++i) {
#pragma unroll
            for (int kk = 0; kk < 4; ++kk) {
                const v4u zp = (v4u){pk2(z[kk][0], z[kk][1]), pk2(z[kk][2], z[kk][3]), pk2(z[kk][4], z[kk][5]), pk2(z[kk][6], z[kk][7])};
                acc[i] = __builtin_amdgcn_mfma_f32_16x16x32_bf16(cf[kk], __builtin_bit_cast(bf16x8, zp), acc[i], 0, 0, 0);
                if (i < 7) {
#pragma unroll
                    for (int j = 0; j < 4; ++j) { const float zr = z[kk][2 * j], zi = z[kk][2 * j + 1], lr = l16[kk][2 * j], li = l16[kk][2 * j + 1]; z[kk][2 * j] = lr * zr - li * zi; z[kk][2 * j + 1] = lr * zi + li * zr; }
                }
            }
        }
    }
    asm volatile("" : "+v"(lane)); fr = lane & 15; kq = lane >> 4;
    const f32x4 dsk = *(const GAS f32x4*)(A.in[13] + g * NHC + 4 * kq);
    bf16* Z = (bf16*)(A.ws + WS_Z);
#pragma unroll
    for (int i = 0; i < 8; ++i) { const int t = 16 * i + fr;
        const v2u uu = *(const LAS v2u*)(ut + (kq >> 1) * 2304 + (16 + t) * 16 + (kq & 1) * 8);
        const float y0 = acc[i][0] + dsk[0] * bflo(uu.x), y1 = acc[i][1] + dsk[1] * bfhi(uu.x), y2 = acc[i][2] + dsk[2] * bflo(uu.y), y3 = acc[i][3] + dsk[3] * bfhi(uu.y);
        *(GAS v2u*)(Z + (size_t)(gc * CHUNK + t) * SW + g * NHC + 4 * kq) = (v2u){pk2(gelu_t(y0), gelu_t(y1)), pk2(gelu_t(y2), gelu_t(y3))}; }
    __syncthreads();
}
__device__ __forceinline__ void p4_phase(const Args& A, const Frame& F) {
    for (int u = F.vcu; u < NG * (T / CHUNK / 8); u += F.G) p4_ypass_unit(A, F, u);
}
struct P5Order {
    const char *GM, *WBT, *Z, *GLUT; int G, c;
    __device__ __forceinline__ bool next(int i, pg8::Unit& u) const {
        const long L = (long)i * G + c; if (L >= 384) return false;
        const bool glu = L >= 256; int wgid = glu ? (int)L - 256 : (int)L; const int nN = glu ? 2 : 4, nwg = 64 * nN;
        { const int q = nwg / 8, xcd = wgid % 8, off = wgid / 8; wgid = xcd * q + off; }
        const int nig = 8 * nN, gid = wgid / nig, fm = gid * 8;
        u.pm = fm + ((wgid % nig) % 8); u.pn = (wgid % nig) / 8; u.aux = glu ? 1 : 0;
        u.abase = (glu ? Z : GM) + (size_t)u.pm * 256 * SW * 2; u.b0 = (glu ? GLUT : WBT) + (size_t)u.pn * 256 * SW * 2; u.b1 = u.b0 + (size_t)128 * SW * 2; return true;
    }
    static constexpr bool GATHER = false;
    __device__ __forceinline__ void aoff(const pg8::Unit&, const int (&R)[2], const int (&C)[2], unsigned (&va)[2][2]) const {
#pragma unroll
        for (int h = 0; h < 2; ++h)
#pragma unroll
            for (int i = 0; i < 2; ++i) va[h][i] = (unsigned)((h * 128 + R[i]) * SW + C[i]) * 2u;
    }
};
struct EpiP5 {
    static constexpr bool PERM = true;
    const bf16* PA; const bf16* Z; const float* glu_b; bf16* MB; bf16* OA;
    __device__ __forceinline__ void operator()(const pg8::f32x4 (&acc)[2][2][4][2], const pg8::Unit& u, int wr, int wc, int fr, int fq) const {
        const int row0 = u.pm * 256 + wr * 64 + fr, col0 = u.pn * 256 + wc * 32 + 8 * fq;
        if (u.aux == 0) {
#pragma unroll
            for (int ai = 0; ai < 2; ++ai)
#pragma unroll
                for (int m = 0; m < 4; ++m) { const size_t row = (size_t)(row0 + ai * 128 + m * 16);
#pragma unroll
                    for (int bj = 0; bj < 2; ++bj) { const int col = col0 + bj * 128;
                        const v4u s = *(const GAS v4u*)(PA + row * PW + (SW + 2 * GW + D) + col);
                        const pg8::f32x4 a0 = acc[ai][bj][m][0], a1 = acc[ai][bj][m][1];
                        *(GAS v4u*)(MB + row * D + col) = (v4u){pk2(bflo(s.x) * a0[0], bfhi(s.x) * a0[1]), pk2(bflo(s.y) * a0[2], bfhi(s.y) * a0[3]), pk2(bflo(s.z) * a1[0], bfhi(s.z) * a1[1]), pk2(bflo(s.w) * a1[2], bfhi(s.w) * a1[3])}; } }
        } else {
#pragma unroll
            for (int bj = 0; bj < 2; ++bj) { const int col = col0 + bj * 128;
                const f32x4 b0 = *(const GAS f32x4*)(glu_b + col), b1 = *(const GAS f32x4*)(glu_b + col + 4);
#pragma unroll
                for (int ai = 0; ai < 2; ++ai)
#pragma unroll
                    for (int m = 0; m < 4; ++m) { const size_t row = (size_t)(row0 + ai * 128 + m * 16);
                        const v4u s = *(const GAS v4u*)(Z + row * SW + col);
                        const pg8::f32x4 a0 = acc[ai][bj][m][0], a1 = acc[ai][bj][m][1];
                        *(GAS v4u*)(OA + row * SW + col) = (v4u){pk2(bflo(s.x) * sigm(a0[0] + b0[0]), bfhi(s.x) * sigm(a0[1] + b0[1])), pk2(bflo(s.y) * sigm(a0[2] + b0[2]), bfhi(s.y) * sigm(a0[3] + b0[3])),
                                                                   pk2(bflo(s.z) * sigm(a1[0] + b1[0]), bfhi(s.z) * sigm(a1[1] + b1[1])), pk2(bflo(s.w) * sigm(a1[2] + b1[2]), bfhi(s.w) * sigm(a1[3] + b1[3]))}; } }
        }
    }
};
__device__ __forceinline__ void p5_phase(const Args& A, const Frame& F) {
    P5Order S{(const char*)(A.ws + WS_GM), (const char*)(A.ws + WS_WBT), (const char*)(A.ws + WS_Z), (const char*)(A.ws + WS_GLUT), F.G, (int)blockIdx.x};
    EpiP5 E{(const bf16*)(A.ws + WS_RX), (const bf16*)(A.ws + WS_Z), A.in[15], (bf16*)(A.ws + WS_MB), (bf16*)(A.ws + WS_OA)};
    pg8::gemm_phase<EpiP5, P5Order>(F.lds, SW, S, E);
}
struct EpiP6 {
    static constexpr bool PERM = true;
    const bf16* PA; const bf16* MB; bf16* MRG;
    __device__ __forceinline__ void operator()(const pg8::f32x4 (&acc)[2][2][4][2], const pg8::Unit& u, int wr, int wc, int fr, int fq) const {
        const int row0 = u.pm * 256 + wr * 64 + fr, col0 = u.pn * 256 + wc * 32 + 8 * fq;
#pragma unroll
        for (int ai = 0; ai < 2; ++ai)
#pragma unroll
            for (int m = 0; m < 4; ++m) { const size_t row = (size_t)(row0 + ai * 128 + m * 16);
#pragma unroll
                for (int bj = 0; bj < 2; ++bj) { const int col = col0 + bj * 128;
                    const v4u s = *(const GAS v4u*)(PA + row * PW + (SW + 2 * GW) + col); const v4u q = *(const GAS v4u*)(MB + row * D + col);
                    const pg8::f32x4 a0 = acc[ai][bj][m][0], a1 = acc[ai][bj][m][1];
                    *(GAS v4u*)(MRG + row * D + col) = (v4u){pk2(bflo(s.x) * a0[0] + bflo(q.x), bfhi(s.x) * a0[1] + bfhi(q.x)), pk2(bflo(s.y) * a0[2] + bflo(q.y), bfhi(s.y) * a0[3] + bfhi(q.y)),
                                                            pk2(bflo(s.z) * a1[0] + bflo(q.z), bfhi(s.z) * a1[1] + bfhi(q.z)), pk2(bflo(s.w) * a1[2] + bflo(q.w), bfhi(s.w) * a1[3] + bfhi(q.w))}; } }
    }
};
__device__ __forceinline__ void p6_phase(const Args& A, const Frame& F) {
    DenseOrder S; S.init(A.ws + WS_OA, A.ws + WS_WAT, T, D, SW, F.G, (int)blockIdx.x);
    EpiP6 E{(const bf16*)(A.ws + WS_RX), (const bf16*)(A.ws + WS_MB), (bf16*)(A.ws + WS_MRG)};
    pg8::gemm_phase<EpiP6, DenseOrder>(F.lds, SW, S, E);
}
struct EpiP7 {
    static constexpr bool PERM = false;
    const float* x; const float* mod; float* X1;
    __device__ __forceinline__ void operator()(const pg8::f32x4 (&acc)[2][2][4][2], const pg8::Unit& u, int wr, int wc, int fr, int fq) const {
        const int row0 = u.pm * 256 + wr * 64 + fr, col0 = u.pn * 256 + wc * 32 + 4 * fq;
        const float* g1 = mod + ((u.pm * 256) / SEQ) * (NMOD * D) + 2 * D;
        f32x4 gv[2][2];
#pragma unroll
        for (int bj = 0; bj < 2; ++bj)
#pragma unroll
            for (int n = 0; n < 2; ++n) gv[bj][n] = *(const GAS f32x4*)(g1 + col0 + bj * 128 + n * 16);
#pragma unroll
        for (int ai = 0; ai < 2; ++ai)
#pragma unroll
            for (int m = 0; m < 4; ++m) { const size_t off = (size_t)(row0 + ai * 128 + m * 16) * D + col0;
#pragma unroll
                for (int bj = 0; bj < 2; ++bj)
#pragma unroll
                    for (int n = 0; n < 2; ++n) { const f32x4 xv = *(const GAS f32x4*)(x + off + bj * 128 + n * 16); *(GAS f32x4*)(X1 + off + bj * 128 + n * 16) = xv + gv[bj][n] * acc[ai][bj][m][n]; } }
    }
};
__device__ __forceinline__ void p7_phase(const Args& A, const Frame& F) {
    DenseOrder S; S.init(A.ws + WS_MRG, A.ws + WS_WOT, T, D, D, F.G, (int)blockIdx.x);
    EpiP7 E{A.in[0], (const float*)(A.ws + WS_MOD), (float*)(A.ws + WS_X1)};
    pg8::gemm_phase<EpiP7, DenseOrder>(F.lds, D, S, E);
}
constexpr size_t WS_TE = WS_SEG + 1024;
constexpr int R_STRIDE = 2064, R_HI = 0, R_LO = 16 * R_STRIDE, R_PL = 2 * 16 * R_STRIDE, R_LG = R_PL + 8 * 2048, R_HIST = R_LG + 2048, R_END = R_HIST + 128;
static_assert(R_END <= RING_BYTES, "router LDS map");
__device__ __forceinline__ void p8_phase(const Args& A, const Frame& F) {
    LAS unsigned char* lds = F.lds;
    const int lane = ((int)threadIdx.x & 63), w = F.wave, tid = ((int)threadIdx.x), fr = lane & 15, kq = lane >> 4;
    const float* mod = (const float*)(A.ws + WS_MOD);
    const float* X1 = (const float*)(A.ws + WS_X1);
    bf16* H2 = (bf16*)(A.ws + WS_H2);
    const bf16* RW = (const bf16*)(A.ws + WS_RWT);
    if (tid < 32) *(LAS int*)(lds + R_HIST + tid * 4) = 0;
    for (int tile = blockIdx.x; tile < T / 16; tile += F.G) {
#pragma unroll
        for (int i = 0; i < 2; ++i) { const int tl = 2 * w + i, t = tile * 16 + tl, b = t / SEQ;
            const GAS f32x4* xr = (const GAS f32x4*)(X1 + (size_t)t * D) + lane;
            f32x4 v[4]; float s = 0.f;
#pragma unroll
            for (int j = 0; j < 4; ++j) { v[j] = xr[64 * j]; s += (v[j].x * v[j].x + v[j].y * v[j].y) + (v[j].z * v[j].z + v[j].w * v[j].w); }
            const float r = rsqrtf(wave_sum(s) * (1.f / D) + EPS);
            const float* mb = mod + b * (NMOD * D);
#pragma unroll
            for (int j = 0; j < 4; ++j) { const f32x4 gg = ((const GAS f32x4*)A.in[23])[lane + 64 * j], sh = ((const GAS f32x4*)(mb + 3 * D))[lane + 64 * j], sc = ((const GAS f32x4*)(mb + 4 * D))[lane + 64 * j];
                const f32x4 o = v[j] * r * gg * (sc + 1.f) + sh;
                const unsigned h0 = f2bf(o.x), h1 = f2bf(o.y), h2_ = f2bf(o.z), h3 = f2bf(o.w);
                const v2u hi = (v2u){h0 | (h1 << 16), h2_ | (h3 << 16)};
                const v2u lo = (v2u){pk2(o.x - bf2f((unsigned short)h0), o.y - bf2f((unsigned short)h1)), pk2(o.z - bf2f((unsigned short)h2_), o.w - bf2f((unsigned short)h3))};
                ((GAS v2u*)(H2 + (size_t)t * D))[lane + 64 * j] = hi;
                *(LAS v2u*)(lds + R_HI + tl * R_STRIDE + (lane + 64 * j) * 8) = hi; *(LAS v2u*)(lds + R_LO + tl * R_STRIDE + (lane + 64 * j) * 8) = lo; } }
        LDS_WAIT(); __syncthreads();
        { f32x4 acc[2] = {(f32x4){0.f, 0.f, 0.f, 0.f}, (f32x4){0.f, 0.f, 0.f, 0.f}};
#pragma unroll
          for (int kk = 0; kk < 4; ++kk) { const int k0 = 128 * w + 32 * kk + 8 * kq;
              const bf16x8 hh = *(const LAS bf16x8*)(lds + R_HI + fr * R_STRIDE + k0 * 2), hl = *(const LAS bf16x8*)(lds + R_LO + fr * R_STRIDE + k0 * 2);
#pragma unroll
              for (int nb = 0; nb < 2; ++nb) { const bf16x8 wh = *(const GAS bf16x8*)(RW + (size_t)(16 * nb + fr) * D + k0), wl = *(const GAS bf16x8*)(RW + (size_t)NE * D + (size_t)(16 * nb + fr) * D + k0);
                  acc[nb] = __builtin_amdgcn_mfma_f32_16x16x32_bf16(wh, hh, acc[nb], 0, 0, 0);
                  acc[nb] = __builtin_amdgcn_mfma_f32_16x16x32_bf16(wh, hl, acc[nb], 0, 0, 0);
                  acc[nb] = __builtin_amdgcn_mfma_f32_16x16x32_bf16(wl, hh, acc[nb], 0, 0, 0); } }
#pragma unroll
          for (int nb = 0; nb < 2; ++nb) *(LAS f32x4*)(lds + R_PL + w * 2048 + fr * 128 + (16 * nb + 4 * kq) * 4) = acc[nb]; }
        LDS_WAIT(); __syncthreads();
        { const int t = tid >> 5, e = tid & 31; float lg = A.in[25][e];
#pragma unroll
          for (int q = 0; q < 8; ++q) lg += *(const LAS float*)(lds + R_PL + q * 2048 + t * 128 + e * 4);
          *(LAS float*)(lds + R_LG + t * 128 + e * 4) = lg; }
        LDS_WAIT(); __syncthreads();
        if (tid < 16) { const int t = tile * 16 + tid; const LAS float* lg = (const LAS float*)(lds + R_LG + tid * 128);
            int idx[4]; float val[4]; unsigned used = 0u;
#pragma unroll
            for (int k = 0; k < 4; ++k) { int bi = 0; float bv = -INFINITY;
                for (int e = 0; e < NE; ++e) { const float x = lg[e]; if (!((used >> e) & 1u) && x > bv) { bv = x; bi = e; } }
                used |= 1u << bi; idx[k] = bi; val[k] = bv; }
            float ex[4], den = 0.f;
#pragma unroll
            for (int k = 0; k < 4; ++k) { ex[k] = __expf(val[k] - val[0]); den += ex[k]; }
            const float inv = 1.f / den;
            *(GAS v4i*)((int*)(A.ws + WS_TOPI) + t * 4) = (v4i){idx[0], idx[1], idx[2], idx[3]};
            *(GAS f32x4*)((float*)(A.ws + WS_TOPW) + t * 4) = (f32x4){ex[0] * inv, ex[1] * inv, ex[2] * inv, ex[3] * inv};
#pragma unroll
            for (int k = 0; k < 4; ++k) __hip_atomic_fetch_add((LAS int*)(lds + R_HIST + idx[k] * 4), 1, __ATOMIC_RELAXED, __HIP_MEMORY_SCOPE_WORKGROUP); }
        LDS_WAIT(); __syncthreads();
    }
    if (tid < 32) ((int*)(A.ws + WS_ROUTE))[blockIdx.x * NE + tid] = *(LAS int*)(lds + R_HIST + tid * 4);
}

__device__ __forceinline__ void p9_phase(const Args& A, const Frame& F) {
    LAS int* li = (LAS int*)F.lds;
    const int tid = ((int)threadIdx.x), lane = ((int)threadIdx.x & 63), me = blockIdx.x;
    const int* blk = (const int*)(A.ws + WS_ROUTE);
    { const int j = tid >> 5, e = tid & 31; int tot = 0, bef = 0;
      for (int b = j; b < F.G; b += 16) { const int c = blk[b * NE + e]; tot += c; bef += (b < me) ? c : 0; }
      li[j * 32 + e] = tot; li[512 + j * 32 + e] = bef; }
    __syncthreads();
    if (tid < 32) { int tot = 0, bef = 0; for (int j = 0; j < 16; ++j) { tot += li[j * 32 + tid]; bef += li[512 + j * 32 + tid]; } li[1024 + tid] = tot; li[1056 + tid] = bef; li[1152 + tid] = 0; }
    __syncthreads();
    if (tid == 0) { int a = 0; for (int e = 0; e < NE; ++e) { li[1088 + e] = a; a += (li[1024 + e] + 255) / 256 * 256; } li[1088 + NE] = a; }
    __syncthreads();
    int* srow = (int*)(A.ws + WS_SROW); int* pos_of = (int*)(A.ws + WS_POS); const int* topi = (const int*)(A.ws + WS_TOPI);
    if (F.wave == 0) {
        for (int tile = me; tile < T / 16; tile += F.G) {
            const int t = tile * 16 + (lane >> 2), ex = topi[t * 4 + (lane & 3)];
            int rank = 0, cnt_mine = 0;
            for (int e = 0; e < NE; ++e) { const unsigned long long m = __ballot(ex == e); if (ex == e) rank = __popcll(m & ((1ull << lane) - 1ull)); if (lane == e) cnt_mine = __popcll(m); }
            const int pos = li[1088 + ex] + li[1056 + ex] + li[1152 + ex] + rank;
            pos_of[t * 4 + (lane & 3)] = pos; srow[pos] = t;
            asm volatile("s_waitcnt lgkmcnt(0)" ::: "memory");
            if (lane < 32) li[1152 + lane] += cnt_mine;
            asm volatile("s_waitcnt lgkmcnt(0)" ::: "memory");
        }
    }
    for (int e = me; e < NE; e += F.G) { const int p0 = li[1088 + e] + li[1024 + e], p1 = li[1088 + e + 1]; for (int r = p0 + tid; r < p1; r += NTHREADS) srow[r] = 0; }
    if (me == 0) { if (tid <= NE) ((int*)(A.ws + WS_SEG))[tid] = li[1088 + tid];
        const int nt = li[1088 + NE] / 256; for (int r = tid; r < nt; r += NTHREADS) { int e = 0; for (int j = 1; j < NE; ++j) e = (r * 256 >= li[1088 + j]) ? j : e; ((int*)(A.ws + WS_TE))[r] = e; } }
    __syncthreads();
}

struct MoeOrder1 {
    const char* H2; const char* W1T; const int* srow; const int* te; int NT, G, c;
    __device__ __forceinline__ bool next(int i, pg8::Unit& u) const {
        const int L = i * G + c, rt = L >> 3, ct = L & 7; if (rt >= NT) return false;
        const int e = te[rt]; u.pm = rt; u.pn = ct; u.aux = e; u.abase = H2;
        u.b0 = W1T + ((size_t)e * 2 * DE + ct * 128) * D * 2; u.b1 = u.b0 + (size_t)DE * D * 2; return true;
    }
    static constexpr bool GATHER = true;
    __device__ __forceinline__ void aoff(const pg8::Unit& u, const int (&R)[2], const int (&C)[2], unsigned (&va)[2][2]) const {
#pragma unroll
        for (int h = 0; h < 2; ++h)
#pragma unroll
            for (int i = 0; i < 2; ++i) va[h][i] = (unsigned)(srow[u.pm * 256 + h * 128 + R[i]] * D + C[i]) * 2u;
    }
};
struct EpiSwiglu {
    static constexpr bool PERM = true;
    const float* b_in; bf16* ACT;
    __device__ __forceinline__ void operator()(const pg8::f32x4 (&acc)[2][2][4][2], const pg8::Unit& u, int wr, int wc, int fr, int fq) const {
        const int row0 = u.pm * 256 + wr * 64 + fr, col = u.pn * 128 + wc * 32 + 8 * fq;
        const float* bi = b_in + (size_t)u.aux * 2 * DE + col;
        const f32x4 bg0 = *(const GAS f32x4*)bi, bg1 = *(const GAS f32x4*)(bi + 4), bu0 = *(const GAS f32x4*)(bi + DE), bu1 = *(const GAS f32x4*)(bi + DE + 4);
#pragma unroll
        for (int ai = 0; ai < 2; ++ai)
#pragma unroll
            for (int m = 0; m < 4; ++m) { float o[8];
#pragma unroll
                for (int j = 0; j < 8; ++j) { const float gt = fminf(acc[ai][0][m][j >> 2][j & 3] + (j < 4 ? bg0[j & 3] : bg1[j & 3]), 7.f);
                    const float up = fminf(fmaxf(acc[ai][1][m][j >> 2][j & 3] + (j < 4 ? bu0[j & 3] : bu1[j & 3]), -7.f), 7.f);
                    o[j] = (up + 1.f) * (gt * sigm(1.702f * gt)); }
                *(GAS v4u*)(ACT + (size_t)(row0 + ai * 128 + m * 16) * DE + col) = (v4u){pk2(o[0], o[1]), pk2(o[2], o[3]), pk2(o[4], o[5]), pk2(o[6], o[7])}; }
    }
};
__device__ __forceinline__ void p10_phase(const Args& A, const Frame& F) {
    const int NT = ((const int*)(A.ws + WS_SEG))[NE] / 256;
    MoeOrder1 S{(const char*)(A.ws + WS_H2), (const char*)(A.ws + WS_W1T), (const int*)(A.ws + WS_SROW), (const int*)(A.ws + WS_TE), NT, F.G, F.vcu};
    EpiSwiglu E{A.in[27], (bf16*)(A.ws + WS_RX)};
    pg8::gemm_phase<EpiSwiglu, MoeOrder1>(F.lds, D, S, E);
}
struct MoeOrder2 {
    const char* ACT; const char* W2T; const int* te; int NT, G, c;
    __device__ __forceinline__ bool next(int i, pg8::Unit& u) const {
        const int L = i * G + c, rt = L >> 2, ct = L & 3; if (rt >= NT) return false;
        const int e = te[rt]; u.pm = rt; u.pn = ct; u.aux = e; u.abase = ACT + (size_t)rt * 256 * DE * 2;
        u.b0 = W2T + ((size_t)e * D + ct * 256) * DE * 2; u.b1 = u.b0 + (size_t)128 * DE * 2; return true;
    }
    static constexpr bool GATHER = false;
    __device__ __forceinline__ void aoff(const pg8::Unit&, const int (&R)[2], const int (&C)[2], unsigned (&va)[2][2]) const {
#pragma unroll
        for (int h = 0; h < 2; ++h)
#pragma unroll
            for (int i = 0; i < 2; ++i) va[h][i] = (unsigned)((h * 128 + R[i]) * DE + C[i]) * 2u;
    }
};
struct EpiMoe2 {
    static constexpr bool PERM = true;
    const float* b_out; bf16* YS;
    __device__ __forceinline__ void operator()(const pg8::f32x4 (&acc)[2][2][4][2], const pg8::Unit& u, int wr, int wc, int fr, int fq) const {
        const int row0 = u.pm * 256 + wr * 64 + fr, col0 = u.pn * 256 + wc * 32 + 8 * fq;
#pragma unroll
        for (int bj = 0; bj < 2; ++bj) { const int col = col0 + bj * 128; const float* bo = b_out + (size_t)u.aux * D + col;
            const f32x4 b0 = *(const GAS f32x4*)bo, b1 = *(const GAS f32x4*)(bo + 4);
#pragma unroll
            for (int ai = 0; ai < 2; ++ai)
#pragma unroll
                for (int m = 0; m < 4; ++m) { const pg8::f32x4 a0 = acc[ai][bj][m][0] + b0, a1 = acc[ai][bj][m][1] + b1;
                    *(GAS v4u*)(YS + (size_t)(row0 + ai * 128 + m * 16) * D + col) = (v4u){pk2(a0[0], a0[1]), pk2(a0[2], a0[3]), pk2(a1[0], a1[1]), pk2(a1[2], a1[3])}; } }
    }
};
__device__ __forceinline__ void p11_phase(const Args& A, const Frame& F) {
    const int NT = ((const int*)(A.ws + WS_SEG))[NE] / 256;
    MoeOrder2 S{(const char*)(A.ws + WS_RX), (const char*)(A.ws + WS_W2T), (const int*)(A.ws + WS_TE), NT, F.G, F.vcu};
    EpiMoe2 E{A.in[29], (bf16*)(A.ws + WS_RY)};
    pg8::gemm_phase<EpiMoe2, MoeOrder2>(F.lds, DE, S, E);
}
__device__ __forceinline__ void p12_phase(const Args& A, const Frame& F) {
    const int gw = F.vcu * NWAVES + F.wave, NGW = F.G * NWAVES, lane = ((int)threadIdx.x & 63);
    const float* mod = (const float*)(A.ws + WS_MOD); const float* X1 = (const float*)(A.ws + WS_X1); const bf16* YS = (const bf16*)(A.ws + WS_RY);
    for (int t = gw; t < T; t += NGW) { const int b = t / SEQ;
        const v4i ps = *(const GAS v4i*)((const int*)(A.ws + WS_POS) + t * 4); const f32x4 wt = *(const GAS f32x4*)((const float*)(A.ws + WS_TOPW) + t * 4);
        const int pp[4] = {ps.x, ps.y, ps.z, ps.w};
        f32x4 o[4]; float s = 0.f;
#pragma unroll
        for (int j = 0; j < 4; ++j) { f32x4 m = {0.f, 0.f, 0.f, 0.f};
#pragma unroll
            for (int k = 0; k < 4; ++k) { const v2u y = ((const GAS v2u*)(YS + (size_t)pp[k] * D))[lane + 64 * j]; const float wk = wt[k];
                m[0] += wk * bflo(y.x); m[1] += wk * bfhi(y.x); m[2] += wk * bflo(y.y); m[3] += wk * bfhi(y.y); }
            const f32x4 xv = ((const GAS f32x4*)(X1 + (size_t)t * D))[lane + 64 * j], g2 = ((const GAS f32x4*)(mod + b * (NMOD * D) + 5 * D))[lane + 64 * j];
            o[j] = xv + g2 * m; s += (o[j].x * o[j].x + o[j].y * o[j].y) + (o[j].z * o[j].z + o[j].w * o[j].w); }
        const float r = rsqrtf(wave_sum(s) * (1.f / D) + EPS);
#pragma unroll
        for (int j = 0; j < 4; ++j) { const f32x4 fg = ((const GAS f32x4*)A.in[30])[lane + 64 * j]; ((GAS f32x4*)(A.out + (size_t)t * D))[lane + 64 * j] = o[j] * r * fg; }
    }
}
constexpr int NPHASE = 13;
__global__ void __launch_bounds__(NTHREADS, 2) mega(Args args) {
    extern __shared__ __attribute__((aligned(16))) unsigned char lds_[];
    Frame F;
    F.lds = (LAS unsigned char*)lds_;
    F.wave = __builtin_amdgcn_readfirstlane((int)threadIdx.x >> 6);
    F.G = gridDim.x; { const int bx = blockIdx.x; F.vcu = (F.G % 8 == 0) ? (bx % 8) * (F.G / 8) + bx / 8 : bx; }
    for (int u = threadIdx.x; u < (LDS_BYTES - LDSCTL_OFF) / 4; u += NTHREADS) ((LAS unsigned*)(F.lds + LDSCTL_OFF))[u] = 0u;
    __syncthreads();
    XcdBarrier bar = xcd_barrier_post((unsigned*)(args.ws + WS_CTL) + CW_BAR, (volatile LAS unsigned*)(F.lds + MISC_OFF) + 8);
    const int lo = args.ph_lo, hi = args.ph_hi;
#define IN(k) (lo <= (k) && (k) < hi)
#define SEAM(k) do { if (IN(k) && IN((k) + 1)) xcd_barrier(bar); } while (0)
    if (IN(0)) { p0_prologue(args, F); } SEAM(0);
    if (IN(1)) { p1_h1(args, F); } SEAM(1);
    if (IN(2)) { p2_proj(args, F); } SEAM(2);
    if (IN(3)) { p3_phase(args, F); } SEAM(3);
    if (IN(4)) { p4_phase(args, F); } SEAM(4);
    if (IN(5)) { p5_phase(args, F); } SEAM(5);
    if (IN(6)) { p6_phase(args, F); } SEAM(6);
    if (IN(7)) { p7_phase(args, F); } SEAM(7);
    if (IN(8)) { p8_phase(args, F); } SEAM(8);
    if (IN(9)) { p9_phase(args, F); } SEAM(9);
    if (IN(10)) { p10_phase(args, F); } SEAM(10);
    if (IN(11)) { p11_phase(args, F); } SEAM(11);
    if (IN(12)) { p12_phase(args, F); }
#undef IN
#undef SEAM
}
}
namespace nv {

__device__ __forceinline__ float sigmoidf_(float x) { return 1.f / (1.f + __expf(-x)); }
__device__ __forceinline__ float gelu_tanh(float x) { const float u = 0.7978845608028654f * (x + 0.044715f * x * x * x); return 0.5f * x * (1.f + tanhf(u)); }

__device__ __forceinline__ float block_sum_256(float v, float* sm) {
#pragma unroll
    for (int o = 32; o > 0; o >>= 1) v += __shfl_xor(v, o);
    __syncthreads();
    if ((threadIdx.x & 63) == 0) sm[threadIdx.x >> 6] = v;
    __syncthreads();
    return sm[0] + sm[1] + sm[2] + sm[3];
}

__global__ void k_mod(const float* __restrict__ c, const float* __restrict__ ada_w, const float* __restrict__ ada_b, float* __restrict__ mod) {
    const int j = blockIdx.x * blockDim.x + threadIdx.x, b = blockIdx.y;
    float acc = ada_b[j];
    for (int k = 0; k < D; ++k) { const float cv = c[b * D + k]; acc += cv * sigmoidf_(cv) * ada_w[(size_t)k * (NMOD * D) + j]; }
    mod[b * (NMOD * D) + j] = acc;
}

__global__ void k_norm_mod(const float* __restrict__ x, const float* __restrict__ g, const float* __restrict__ mod, int shift_off, int scale_off, float* __restrict__ h) {
    __shared__ float sm[8];
    const int t = blockIdx.x, b = t / SEQ;
    const float4 v = ((const float4*)(x + (size_t)t * D))[threadIdx.x];
    const float ss = block_sum_256(v.x * v.x + v.y * v.y + v.z * v.z + v.w * v.w, sm);
    const float r = rsqrtf(ss * (1.f / D) + EPS);
    const int d0 = threadIdx.x * 4;
    const float* mb = mod + b * (NMOD * D);
    float o[4] = {v.x, v.y, v.z, v.w};
#pragma unroll
    for (int i = 0; i < 4; ++i) o[i] = o[i] * r * g[d0 + i] * (1.f + mb[scale_off + d0 + i]) + mb[shift_off + d0 + i];
    ((float4*)(h + (size_t)t * D))[threadIdx.x] = make_float4(o[0], o[1], o[2], o[3]);
}

template <bool DUAL, class AF, class EF>
__device__ __forceinline__ void sgemm_tile(int m0, int n0, int K, const float* __restrict__ Bm, int ldb, int dual_off, AF af, EF ef) {
    __shared__ float As[16][68], Bs[16][68], Bs2[DUAL ? 16 : 1][68];
    const int tid = threadIdx.x, tx = tid & 15, ty = tid >> 4;
    float acc[4][4], acc2[4][4];
#pragma unroll
    for (int i = 0; i < 4; ++i)
#pragma unroll
        for (int j = 0; j < 4; ++j) { acc[i][j] = 0.f; acc2[i][j] = 0.f; }
    for (int k0 = 0; k0 < K; k0 += 16) {
#pragma unroll
        for (int q = 0; q < 4; ++q) { const int idx = tid + q * 256, m = idx >> 4, k = idx & 15; As[k][m] = af(m0 + m, k0 + k); }
#pragma unroll
        for (int q = 0; q < 4; ++q) { const int idx = tid + q * 256, k = idx >> 6, n = idx & 63; Bs[k][n] = Bm[(size_t)(k0 + k) * ldb + n0 + n];
            if (DUAL) Bs2[k][n] = Bm[(size_t)(k0 + k) * ldb + n0 + n + dual_off]; }
        __syncthreads();
#pragma unroll
        for (int k = 0; k < 16; ++k) {
            float a[4], b[4], b2[4];
#pragma unroll
            for (int i = 0; i < 4; ++i) a[i] = As[k][ty * 4 + i];
#pragma unroll
            for (int j = 0; j < 4; ++j) { b[j] = Bs[k][tx * 4 + j]; b2[j] = DUAL ? Bs2[k][tx * 4 + j] : 0.f; }
#pragma unroll
            for (int i = 0; i < 4; ++i)
#pragma unroll
                for (int j = 0; j < 4; ++j) { acc[i][j] += a[i] * b[j]; if (DUAL) acc2[i][j] += a[i] * b2[j]; }
        }
        __syncthreads();
    }
#pragma unroll
    for (int i = 0; i < 4; ++i)
#pragma unroll
        for (int j = 0; j < 4; ++j) ef(m0 + ty * 4 + i, n0 + tx * 4 + j, acc[i][j], acc2[i][j]);
}

__global__ void k_gemm_plain(const float* __restrict__ A, int lda, const float* __restrict__ Bm, int ldb, float* __restrict__ C, int ldc, int K) {
    const int m0 = blockIdx.y * 64, n0 = blockIdx.x * 64;
    sgemm_tile<false>(m0, n0, K, Bm, ldb, 0, [&](int m, int k) { return A[(size_t)m * lda + k]; },
                      [&](int m, int n, float a, float) { C[(size_t)m * ldc + n] = a; });
}
__global__ void k_gemm_glu(const float* __restrict__ Z, const float* __restrict__ W, const float* __restrict__ bias, float* __restrict__ O) {
    const int m0 = blockIdx.y * 64, n0 = blockIdx.x * 64;
    sgemm_tile<false>(m0, n0, SW, W, SW, 0, [&](int m, int k) { return Z[(size_t)m * SW + k]; },
                      [&](int m, int n, float a, float) { O[(size_t)m * SW + n] = Z[(size_t)m * SW + n] * sigmoidf_(a + bias[n]); });
}
template <bool PRE> __global__ void k_gemm_branch(const float* __restrict__ A, const float* __restrict__ W, const float* __restrict__ proj, int gate_off, float* __restrict__ merged, int accumulate) {
    const int m0 = blockIdx.y * 64, n0 = blockIdx.x * 64;
    sgemm_tile<false>(m0, n0, SW, W, D, 0, [&](int m, int k) { return A[(size_t)m * SW + k]; },
                      [&](int m, int n, float a, float) { const float gv = proj[(size_t)m * PW + gate_off + n]; const float v = (PRE ? gv : sigmoidf_(gv)) * a;
                          float* p = merged + (size_t)m * D + n; *p = accumulate ? (*p + v) : v; });
}
__global__ void k_gemm_out(const float* __restrict__ merged, const float* __restrict__ W, const float* __restrict__ x, const float* __restrict__ mod, float* __restrict__ x1) {
    const int m0 = blockIdx.y * 64, n0 = blockIdx.x * 64;
    sgemm_tile<false>(m0, n0, D, W, D, 0, [&](int m, int k) { return merged[(size_t)m * D + k]; },
                      [&](int m, int n, float a, float) { const int b = m / SEQ; x1[(size_t)m * D + n] = x[(size_t)m * D + n] + mod[b * (NMOD * D) + 2 * D + n] * a; });
}

__global__ void k_s5(const float* __restrict__ proj, const float* __restrict__ a_re, const float* __restrict__ a_im, const float* __restrict__ log_dt,
                     const float* __restrict__ b_re, const float* __restrict__ b_im, const float* __restrict__ c_re, const float* __restrict__ c_im,
                     const float* __restrict__ dskip, float* __restrict__ z) {
    __shared__ float s_re[64], s_im[64], cre[16][65], cim[16][65];
    const int p = threadIdx.x, b = blockIdx.x / NG, g = blockIdx.x % NG;
    const double dt = exp((double)log_dt[g]);
    const double lr = a_re[g * NP + p], li = a_im[g * NP + p];
    const double mag = exp(lr * dt), lbr_d = mag * cos(li * dt), lbi_d = mag * sin(li * dt);
    const double nr = lbr_d - 1.0, ni = lbi_d, den = lr * lr + li * li;
    const double cfr = (nr * lr + ni * li) / den, cfi = (ni * lr - nr * li) / den;
    const float lbr = (float)lbr_d, lbi = (float)lbi_d;
    float bbr[16], bbi[16];
#pragma unroll
    for (int h = 0; h < 16; ++h) { const double br = b_re[(g * NP + p) * NHC + h], bi = b_im[(g * NP + p) * NHC + h];
        bbr[h] = (float)(cfr * br - cfi * bi); bbi[h] = (float)(cfr * bi + cfi * br); }
    for (int i = p; i < 16 * 64; i += 64) { const int ho = i / 64, pp = i % 64; cre[ho][pp] = c_re[(g * NHC + ho) * NP + pp]; cim[ho][pp] = c_im[(g * NHC + ho) * NP + pp]; }
    __syncthreads();
    float sr = 0.f, si = 0.f;
    const float dsk = (p < 16) ? dskip[g * NHC + p] : 0.f;
    for (int s = 0; s < SEQ; ++s) {
        const size_t t = (size_t)b * SEQ + s;
        const float4* up = (const float4*)(proj + t * PW + g * NHC);
        const float4 u0 = up[0], u1 = up[1], u2 = up[2], u3 = up[3];
        const float u[16] = {u0.x, u0.y, u0.z, u0.w, u1.x, u1.y, u1.z, u1.w, u2.x, u2.y, u2.z, u2.w, u3.x, u3.y, u3.z, u3.w};
        float br = 0.f, bi = 0.f;
#pragma unroll
        for (int h = 0; h < 16; ++h) { br += bbr[h] * u[h]; bi += bbi[h] * u[h]; }
        const float nsr = lbr * sr - lbi * si + br, nsi = lbr * si + lbi * sr + bi;
        sr = nsr; si = nsi;
        s_re[p] = sr; s_im[p] = si;
        __syncthreads();
        if (p < 16) {
            float y = 0.f;
            for (int pp = 0; pp < 64; ++pp) y += cre[p][pp] * s_re[pp] - cim[p][pp] * s_im[pp];
            float up_ = 0.f;
#pragma unroll
            for (int h = 0; h < 16; ++h) up_ = (h == p) ? u[h] : up_;
            y += dsk * up_;
            z[t * SW + g * NHC + p] = gelu_tanh(y);
        }
        __syncthreads();
    }
}

template <bool PRE> __global__ void k_gmlp_ln(const float* __restrict__ proj, const float* __restrict__ lng, const float* __restrict__ lnb, float* __restrict__ gu, float* __restrict__ vn) {
    __shared__ float sm[8];
    const int t = blockIdx.x, i0 = threadIdx.x * 2;
    const float* pr = proj + (size_t)t * PW + SW;
    const float a0 = PRE ? pr[i0] : gelu_tanh(pr[i0]), a1 = PRE ? pr[i0 + 1] : gelu_tanh(pr[i0 + 1]);
    const float v0 = PRE ? pr[GW + i0] : gelu_tanh(pr[GW + i0]), v1 = PRE ? pr[GW + i0 + 1] : gelu_tanh(pr[GW + i0 + 1]);
    gu[(size_t)t * GW + i0] = a0; gu[(size_t)t * GW + i0 + 1] = a1;
    const float mu = block_sum_256(v0 + v1, sm) * (1.f / GW);
    const float d0 = v0 - mu, d1 = v1 - mu;
    const float var = block_sum_256(d0 * d0 + d1 * d1, sm) * (1.f / GW);
    const float r = rsqrtf(var + EPS);
    vn[(size_t)t * GW + i0] = d0 * r * lng[i0] + lnb[i0];
    vn[(size_t)t * GW + i0 + 1] = d1 * r * lng[i0 + 1] + lnb[i0 + 1];
}
__global__ void k_gmlp_mix(const float* __restrict__ gu, const float* __restrict__ vn, const float* __restrict__ ws, const float* __restrict__ bs, float* __restrict__ gm) {
    const int blk = blockIdx.x, sub = blk & 31, h = (blk >> 5) & 7, chunk = blk >> 8;
    const int tl = sub * 4 + (threadIdx.x >> 6), c = threadIdx.x & 63;
    const float* w = ws + ((size_t)h * CHUNK + tl) * CHUNK;
    const float* v = vn + (size_t)chunk * CHUNK * GW + h * HD + c;
    float acc = 0.f;
    for (int s = 0; s <= tl; ++s) acc += w[s] * v[(size_t)s * GW];
    const size_t o = ((size_t)chunk * CHUNK + tl) * GW + h * HD + c;
    gm[o] = gu[o] * (acc + bs[h * CHUNK + tl]);
}

__global__ void k_router(const float* __restrict__ x1, const float* __restrict__ g2, const float* __restrict__ mod, const float* __restrict__ rw, const float* __restrict__ rb,
                         float* __restrict__ h2, int* __restrict__ topi, float* __restrict__ topw) {
    __shared__ float sm[8], hs[D], part[8][32], lg[32];
    const int t = blockIdx.x, b = t / SEQ;
    const float4 v = ((const float4*)(x1 + (size_t)t * D))[threadIdx.x];
    const float ss = block_sum_256(v.x * v.x + v.y * v.y + v.z * v.z + v.w * v.w, sm);
    const float r = rsqrtf(ss * (1.f / D) + EPS);
    const int d0 = threadIdx.x * 4;
    const float* mb = mod + b * (NMOD * D);
    float o[4] = {v.x, v.y, v.z, v.w};
#pragma unroll
    for (int i = 0; i < 4; ++i) { o[i] = o[i] * r * g2[d0 + i] * (1.f + mb[4 * D + d0 + i]) + mb[3 * D + d0 + i]; hs[d0 + i] = o[i]; }
    ((float4*)(h2 + (size_t)t * D))[threadIdx.x] = make_float4(o[0], o[1], o[2], o[3]);
    __syncthreads();
    { const int e = threadIdx.x & 31, q = threadIdx.x >> 5; float a = 0.f;
      for (int k = q * 128; k < q * 128 + 128; ++k) a += hs[k] * rw[k * NE + e];
      part[q][e] = a; }
    __syncthreads();
    if (threadIdx.x < 32) { float a = rb[threadIdx.x]; for (int q = 0; q < 8; ++q) a += part[q][threadIdx.x]; lg[threadIdx.x] = a; }
    __syncthreads();
    if (threadIdx.x == 0) {
        int idx[4]; float val[4]; unsigned used = 0u;
        for (int k = 0; k < 4; ++k) { int bi = -1; float bv = -INFINITY; for (int e = 0; e < NE; ++e) if (!((used >> e) & 1u) && lg[e] > bv) { bv = lg[e]; bi = e; } used |= 1u << bi; idx[k] = bi; val[k] = bv; }
        float den = 0.f, ex[4];
        for (int k = 0; k < 4; ++k) { ex[k] = __expf(val[k] - val[0]); den += ex[k]; }
        for (int k = 0; k < 4; ++k) { topi[t * 4 + k] = idx[k]; topw[t * 4 + k] = ex[k] / den; }
    }
}

__global__ void k_route(const int* __restrict__ topi, const float* __restrict__ topw, int* __restrict__ seg, int* __restrict__ srow_tok, float* __restrict__ srow_w, int* __restrict__ pos_of) {
    __shared__ int cnt[NE], st[NE + 1];
    const int e = threadIdx.x;
    int c = 0;
    for (int i = 0; i < T * TOPK; ++i) c += (topi[i] == e);
    cnt[e] = c;
    __syncthreads();
    if (e == 0) { int a = 0; for (int j = 0; j < NE; ++j) { st[j] = a; a += (cnt[j] + 255) / 256 * 256; } st[NE] = a; }
    __syncthreads();
    seg[e] = st[e]; if (e == 0) seg[NE] = st[NE];
    int pos = st[e];
    for (int i = 0; i < T * TOPK; ++i) if (topi[i] == e) { srow_tok[pos] = i >> 2; srow_w[pos] = topw[i]; pos_of[i] = pos; ++pos; }
}

__device__ __forceinline__ int find_expert(const int* __restrict__ seg, int row) { int e = 0; for (int j = 1; j < NE; ++j) e = (row >= seg[j]) ? j : e; return e; }

__global__ void k_moe1(const float* __restrict__ h2, const int* __restrict__ seg, const int* __restrict__ srow_tok, const float* __restrict__ w_in, const float* __restrict__ b_in, float* __restrict__ act) {
    const int m0 = blockIdx.y * 64, n0 = blockIdx.x * 64;
    if (m0 >= seg[NE]) return;
    const int e = find_expert(seg, m0);
    const float* W = w_in + (size_t)e * D * 2 * DE; const float* bi = b_in + (size_t)e * 2 * DE;
    sgemm_tile<true>(m0, n0, D, W, 2 * DE, DE, [&](int m, int k) { const int tk = srow_tok[m]; return tk >= 0 ? h2[(size_t)tk * D + k] : 0.f; },
                     [&](int m, int n, float ag, float au) { float gt = fminf(ag + bi[n], 7.f); float up = fminf(fmaxf(au + bi[DE + n], -7.f), 7.f);
                         act[(size_t)m * DE + n] = (up + 1.f) * (gt * sigmoidf_(1.702f * gt)); });
}
__global__ void k_moe2(const float* __restrict__ act, const int* __restrict__ seg, const float* __restrict__ srow_w, const float* __restrict__ w_out, const float* __restrict__ b_out, float* __restrict__ ys) {
    const int m0 = blockIdx.y * 64, n0 = blockIdx.x * 64;
    if (m0 >= seg[NE]) return;
    const int e = find_expert(seg, m0);
    const float* W = w_out + (size_t)e * DE * D; const float* bo = b_out + (size_t)e * D;
    sgemm_tile<false>(m0, n0, DE, W, D, 0, [&](int m, int k) { return act[(size_t)m * DE + k]; },
                      [&](int m, int n, float a, float) { ys[(size_t)m * D + n] = (a + bo[n]) * srow_w[m]; });
}
__global__ void k_final(const float* __restrict__ x1, const float* __restrict__ ys, const int* __restrict__ pos_of, const float* __restrict__ mod, const float* __restrict__ fg, float* __restrict__ out) {
    __shared__ float sm[8];
    const int t = blockIdx.x, b = t / SEQ, d0 = threadIdx.x * 4;
    const float4 xv = ((const float4*)(x1 + (size_t)t * D))[threadIdx.x];
    float m[4] = {0.f, 0.f, 0.f, 0.f};
    for (int k = 0; k < 4; ++k) { const float4 y = ((const float4*)(ys + (size_t)pos_of[t * 4 + k] * D))[threadIdx.x]; m[0] += y.x; m[1] += y.y; m[2] += y.z; m[3] += y.w; }
    const float* g2 = mod + b * (NMOD * D) + 5 * D + d0;
    float o[4] = {xv.x + g2[0] * m[0], xv.y + g2[1] * m[1], xv.z + g2[2] * m[2], xv.w + g2[3] * m[3]};
    const float ss = block_sum_256(o[0] * o[0] + o[1] * o[1] + o[2] * o[2] + o[3] * o[3], sm);
    const float r = rsqrtf(ss * (1.f / D) + EPS);
    ((float4*)(out + (size_t)t * D))[threadIdx.x] = make_float4(o[0] * r * fg[d0], o[1] * r * fg[d0 + 1], o[2] * r * fg[d0 + 2], o[3] * r * fg[d0 + 3]);
}

__global__ void k_bf16_to_f32(const unsigned short* __restrict__ s, float* __restrict__ d, size_t n) { for (size_t i = (size_t)blockIdx.x * blockDim.x + threadIdx.x; i < n; i += (size_t)gridDim.x * blockDim.x) d[i] = __builtin_bit_cast(float, (unsigned)s[i] << 16); }
}
#ifndef REP_PHASE
#define REP_PHASE -1
#define REP_PHASE2 -1
#endif
static int launch_mega(const Args& a0, int lo, int hi, hipStream_t stream) {
    static int grid = 0;
    if (grid == 0) {
        int dev = 0, cus = 0, per_cu = 0;
        if (hipGetDevice(&dev) != hipSuccess || hipDeviceGetAttribute(&cus, hipDeviceAttributeMultiprocessorCount, dev) != hipSuccess) { fprintf(stderr, "kernel_launch: device query failed\n"); grid = -1; return -1; }
        if (hipFuncSetAttribute((const void*)mega, hipFuncAttributeMaxDynamicSharedMemorySize, LDS_BYTES) != hipSuccess) { fprintf(stderr, "kernel_launch: hipFuncSetAttribute failed\n"); grid = -1; return -1; }
        if (hipOccupancyMaxActiveBlocksPerMultiprocessor(&per_cu, (const void*)mega, NTHREADS, LDS_BYTES) != hipSuccess || per_cu < 1) { fprintf(stderr, "kernel_launch: occupancy query says %d blocks per CU\n", per_cu); per_cu = 1; }
        (void)hipGetLastError();
        grid = cus;
    }
    if (grid < 0) return -1;
    Args a = a0; a.ph_lo = lo; a.ph_hi = hi; a.rep = -1; a.pad = 0;
    hipLaunchKernelGGL(mega, dim3(grid), dim3(NTHREADS), LDS_BYTES, stream, a);
    return 0;
}

extern "C" void kernel_launch(void* const* d_in, const int* in_sizes, int n_in, void* d_out, int out_size, void* d_ws, size_t ws_size, hipStream_t stream) {
    if (n_in != 31 || ws_size < 1000 * MiB) { fprintf(stderr, "kernel_launch: unexpected inputs (n_in %d, ws %zu)\n", n_in, ws_size); return; }
    Args a{};
    for (int i = 0; i < 31; ++i) a.in[i] = (const float*)d_in[i];
    a.out = (float*)d_out; a.ws = (unsigned char*)d_ws;
    (void)hipMemsetAsync((char*)d_ws + WS_CTL, 0, CTL_ZERO_BYTES, stream);
    char* ws = (char*)d_ws;
    const float* x = a.in[0];
    float* out = (float*)d_out;
    launch_mega(a, 0, NPHASE, stream);
#if REP_PHASE >= 0
    launch_mega(a, REP_PHASE, REP_PHASE2 + 1, stream);
#endif
}
```

```cpp
#include <hip/hip_runtime.h>
#include <cstdio>
#include <cstdint>
namespace pg8 {
#define PG8_LAS __attribute__((address_space(3)))
typedef unsigned short bf16_t;
typedef short bf16x8 __attribute__((ext_vector_type(8)));
typedef float f32x4 __attribute__((ext_vector_type(4)));
typedef float f32x2 __attribute__((ext_vector_type(2)));
typedef unsigned u32x4 __attribute__((ext_vector_type(4)));
typedef unsigned u32x2 __attribute__((ext_vector_type(2)));
constexpr int BM = 256, BK = 64, HALF = 128, HTB = HALF * BK * 2  , STAGE_BYTES = 8 * HTB, NXCD = 8, WGM = 8;
constexpr int VN_SLOT_OFF = STAGE_BYTES + 1024;

__host__ __device__ __forceinline__ int lds_byte(int r, int c) { const int st = (r >> 4) * 2 + (c >> 5), rr = r & 15, cc = c & 31, ob = rr * 64 + cc * 2; return st * 1024 + (ob ^ (((ob >> 9) & 1) << 5)); }
__host__ __device__ __forceinline__ void stage_rc(int b, int& R, int& C) { const int st = b / 1024, sb = b % 1024, swz = sb ^ (((sb >> 9) & 1) << 5); R = (st >> 1) * 16 + swz / 64; C = (st & 1) * 32 + (swz % 64) / 2; }
__host__ __device__ __forceinline__ int perm32(int rho) { const int n = rho >> 4, i = rho & 15; return 8 * (i >> 2) + 4 * n + (i & 3); }

struct Unit { int pm, pn, aux; const char* abase; const char* b0; const char* b1; };

__device__ __forceinline__ unsigned cvt_pk_bf16(float lo, float hi) { unsigned r; asm volatile("v_cvt_pk_bf16_f32 %0, %1, %2" : "=v"(r) : "v"(lo), "v"(hi)); return r; }

template <class Epi, class Sched>
__device__ __forceinline__ void gemm_phase(PG8_LAS unsigned char* lds, const int K, const Sched& S, const Epi& E) {
    const int tid = threadIdx.x, wid = __builtin_amdgcn_readfirstlane(tid >> 6), lane = tid & 63, wr = wid >> 2, wc = wid & 3, fr = lane & 15, fq = lane >> 4;
    const int nt = K / BK;
    int Rp[2], Cp[2]; unsigned voffB[2];
#pragma unroll
    for (int i = 0; i < 2; ++i) { int R, C; stage_rc(tid * 16 + i * 8192, R, C); Rp[i] = R; Cp[i] = C; const int Rb = Epi::PERM ? ((R & ~31) + perm32(R & 31)) : R; voffB[i] = (unsigned)(Rb * K + C) * 2u; }
    const size_t kstep = (size_t)(BK * 2);
    const unsigned ldsw = (unsigned)wid * 1024u;
    const int aoff = lds_byte(wr * 64 + fr, fq * 8), boff = lds_byte(wc * 32 + fr, fq * 8);
#define PG8_SA(b, h) (((b) * 2 + (h)) * HTB)
#define PG8_SB(b, h) ((4 + (b) * 2 + (h)) * HTB)
#define PG8_STAGE(bufoff, gbase, voff) do { _Pragma("unroll") for (int _i = 0; _i < 2; ++_i) \
        __builtin_amdgcn_global_load_lds((const unsigned*)((const char*)(gbase) + (voff)[_i]), (PG8_LAS unsigned*)(lds + (bufoff) + ldsw + _i * 8192), 16, 0, 0); } while (0)
#define PG8_LDA(dst, b, h) do { _Pragma("unroll") for (int m = 0; m < 4; ++m) _Pragma("unroll") for (int k = 0; k < 2; ++k) dst[m][k] = *(const PG8_LAS bf16x8*)(lds + PG8_SA(b, h) + aoff + m * 2048 + k * 1024); } while (0)
#define PG8_LDB(dst, b, h) do { _Pragma("unroll") for (int n = 0; n < 2; ++n) _Pragma("unroll") for (int k = 0; k < 2; ++k) dst[n][k] = *(const PG8_LAS bf16x8*)(lds + PG8_SB(b, h) + boff + n * 2048 + k * 1024); } while (0)
#define PG8_MMA(ai, bj, At, Bt) do { __builtin_amdgcn_s_setprio(1); _Pragma("unroll") for (int m = 0; m < 4; ++m) _Pragma("unroll") for (int n = 0; n < 2; ++n) _Pragma("unroll") for (int k = 0; k < 2; ++k) \
        acc[ai][bj][m][n] = __builtin_amdgcn_mfma_f32_16x16x32_bf16(Bt[n][k], At[m][k], acc[ai][bj][m][n], 0, 0, 0); __builtin_amdgcn_s_setprio(0); } while (0)
#define PG8_WAIT_V(n) asm volatile("s_waitcnt vmcnt(" #n ")" ::: "memory")
#define PG8_WAIT_L(n) asm volatile("s_waitcnt lgkmcnt(" #n ")" ::: "memory")
#define PG8_BAR __builtin_amdgcn_s_barrier()
#define PG8_SCHED __builtin_amdgcn_sched_barrier(0)
    Unit cur, nxt; int ui = 0;
    if (!S.next(0, cur)) return;
    f32x4 acc[2][2][4][2];
#pragma unroll
    for (int a = 0; a < 2; ++a)
#pragma unroll
        for (int b = 0; b < 2; ++b)
#pragma unroll
            for (int m = 0; m < 4; ++m)
#pragma unroll
                for (int n = 0; n < 2; ++n) acc[a][b][m][n] = (f32x4){0.f, 0.f, 0.f, 0.f};
    bf16x8 At[4][2], B0[2][2], B1[2][2];
    unsigned va[2][2];
    PG8_LAS u32x4* vslot = (PG8_LAS u32x4*)(lds + VN_SLOT_OFF) + tid;
    S.aoff(cur, Rp, Cp, va);
    const char* cA = cur.abase; const char* cB0 = cur.b0; const char* cB1 = cur.b1;
    PG8_STAGE(PG8_SB(0, 0), cB0, voffB); PG8_STAGE(PG8_SB(0, 1), cB1, voffB); PG8_STAGE(PG8_SA(0, 0), cA, va[0]); PG8_STAGE(PG8_SA(0, 1), cA, va[1]);
    if (wr == 1) PG8_BAR;
    PG8_WAIT_V(2); PG8_BAR;
    PG8_STAGE(PG8_SB(1, 0), cB0 + kstep, voffB); PG8_STAGE(PG8_SA(1, 0), cA + kstep, va[0]); PG8_STAGE(PG8_SB(1, 1), cB1 + kstep, voffB);
    PG8_WAIT_V(6); PG8_BAR;
    for (;;) {
        const bool has_next = S.next(ui + 1, nxt);
        if constexpr (Sched::GATHER) { unsigned vn[2][2]; if (has_next) S.aoff(nxt, Rp, Cp, vn); else { vn[0][0] = va[0][0]; vn[0][1] = va[0][1]; vn[1][0] = va[1][0]; vn[1][1] = va[1][1]; }
            *vslot = (u32x4){vn[0][0], vn[0][1], vn[1][0], vn[1][1]}; }
        const char* nA = has_next ? nxt.abase : cA; const char* nB0 = has_next ? nxt.b0 : cB0; const char* nB1 = has_next ? nxt.b1 : cB1;
        for (int t = 0; t < nt; t += 2) {
            const bool last = (t == nt - 2);
            const char* a1 = cA + (size_t)(t + 1) * kstep;
            const char* a2 = last ? nA : cA + (size_t)(t + 2) * kstep;
            const char* b20 = last ? nB0 : cB0 + (size_t)(t + 2) * kstep; const char* b21 = last ? nB1 : cB1 + (size_t)(t + 2) * kstep;
            const char* a3 = a2 + kstep; const char* b30 = b20 + kstep; const char* b31 = b21 + kstep;
            PG8_LDB(B0, 0, 0); PG8_LDB(B1, 0, 1); PG8_SCHED; PG8_LDA(At, 0, 0); PG8_STAGE(PG8_SA(1, 1), a1, va[1]);
            PG8_WAIT_V(8); PG8_WAIT_L(0); PG8_BAR; PG8_MMA(0, 0, At, B0); PG8_MMA(0, 1, At, B1); PG8_BAR; PG8_SCHED;
            if constexpr (Sched::GATHER) { if (last) { const u32x4 q = *vslot; va[0][0] = q[0]; va[0][1] = q[1]; va[1][0] = q[2]; va[1][1] = q[3]; } }
            PG8_LDA(At, 0, 1); PG8_STAGE(PG8_SB(0, 0), b20, voffB); PG8_STAGE(PG8_SB(0, 1), b21, voffB); PG8_STAGE(PG8_SA(0, 0), a2, va[0]);
            PG8_WAIT_V(8); PG8_WAIT_L(0); PG8_BAR; PG8_MMA(1, 0, At, B0); PG8_MMA(1, 1, At, B1); PG8_BAR; PG8_SCHED;
            PG8_LDB(B0, 1, 0); PG8_LDB(B1, 1, 1); PG8_SCHED; PG8_LDA(At, 1, 0); PG8_STAGE(PG8_SA(0, 1), a2, va[1]);
            PG8_WAIT_V(8); PG8_WAIT_L(0); PG8_BAR; PG8_MMA(0, 0, At, B0); PG8_MMA(0, 1, At, B1); PG8_BAR; PG8_SCHED;
            PG8_LDA(At, 1, 1); PG8_STAGE(PG8_SB(1, 0), b30, voffB); PG8_STAGE(PG8_SB(1, 1), b31, voffB); PG8_STAGE(PG8_SA(1, 0), a3, va[0]);
            PG8_WAIT_V(8); PG8_WAIT_L(0); PG8_BAR; PG8_MMA(1, 0, At, B0); PG8_MMA(1, 1, At, B1); PG8_BAR; PG8_SCHED;
        }
        if (wr == 0) PG8_BAR;
        E(acc, cur, wr, wc, fr, fq);
        if (!has_next) break;
#pragma unroll
        for (int a = 0; a < 2; ++a)
#pragma unroll
            for (int b = 0; b < 2; ++b)
#pragma unroll
                for (int m = 0; m < 4; ++m)
#pragma unroll
                    for (int n = 0; n < 2; ++n) acc[a][b][m][n] = (f32x4){0.f, 0.f, 0.f, 0.f};
        cur = nxt; cA = nA; cB0 = nB0; cB1 = nB1; ++ui;
        if (wr == 1) PG8_BAR;
    }
    PG8_WAIT_V(0);
    PG8_BAR;
#undef PG8_SA
#undef PG8_SB
#undef PG8_STAGE
#undef PG8_LDA
#undef PG8_LDB
#undef PG8_MMA
#undef PG8_WAIT_V
#undef PG8_WAIT_L
#undef PG8_BAR
#undef PG8_SCHED
}
}
namespace {
constexpr int D = 1024, NB = 8, SEQ = 2048, T = NB * SEQ, PW = 3584, SW = 512, NG = 32, NP = 64, NHC = 16;
constexpr int GW = 512, NHEAD = 8, HD = 64, CHUNK = 128, NCH = SEQ / CHUNK, NE = 32, TOPK = 4, DE = 1024, NMOD = 6;
constexpr int PADROWS = T * TOPK + NE * 256;
constexpr float EPS = 1e-6f;
constexpr int NWAVES = 8, NTHREADS = NWAVES * 64;
constexpr int MODK = 8;

#define GAS __attribute__((address_space(1)))
#define LAS __attribute__((address_space(3)))
typedef unsigned short bf16;
typedef unsigned v4u __attribute__((ext_vector_type(4)));
typedef unsigned v2u __attribute__((ext_vector_type(2)));
typedef int v4i __attribute__((ext_vector_type(4)));
typedef float f32x4 __attribute__((ext_vector_type(4)));
typedef float f32x2 __attribute__((ext_vector_type(2)));
typedef short bf16x8 __attribute__((ext_vector_type(8)));
typedef GAS unsigned gu32;
#define RLX_AGENT __ATOMIC_RELAXED, __HIP_MEMORY_SCOPE_AGENT
#define LDS_WAIT() asm volatile("s_waitcnt lgkmcnt(0)" ::: "memory")
#define VM_WAIT() asm volatile("s_waitcnt vmcnt(0)" ::: "memory")
__device__ __forceinline__ unsigned f2bf(float f) { unsigned u = __builtin_bit_cast(unsigned, f); return (u + 0x7fffu + ((u >> 16) & 1u)) >> 16; }
__device__ __forceinline__ unsigned pk2(float lo, float hi) { return f2bf(lo) | (f2bf(hi) << 16); }
__device__ __forceinline__ float bf2f(unsigned short b) { return __builtin_bit_cast(float, (unsigned)b << 16); }
__device__ __forceinline__ float bflo(unsigned w) { return __builtin_bit_cast(float, w << 16); }
__device__ __forceinline__ float bfhi(unsigned w) { return __builtin_bit_cast(float, w & 0xffff0000u); }
__device__ __forceinline__ float sigm(float x) { return __builtin_amdgcn_rcpf(1.f + __expf(-x)); }
__device__ __forceinline__ float gelu_t(float x) { const float u = 1.5957691216057308f * (x + 0.044715f * x * x * x); return x * sigm(u); }
__device__ __forceinline__ float wave_sum(float v) {
#pragma unroll
    for (int o = 1; o < 64; o <<= 1) v += __shfl_xor(v, o);
    return v;
}

constexpr size_t MiB = 1u << 20;
constexpr size_t WS_CTL = 0, CTL_ZERO_BYTES = 64 * 1024;
constexpr int CW_BAR = 1024;
constexpr size_t WS_MODP = 1 * MiB;
constexpr size_t WS_MOD = 3 * MiB;
constexpr size_t WS_WSM = 4 * MiB;
constexpr size_t WS_CMT = WS_WSM + 512 * 1024;
constexpr size_t WS_RWT = 5 * MiB;
constexpr size_t WS_ROUTE = 6 * MiB;
constexpr size_t WS_SEG = WS_ROUTE + 192 * 1024, WS_SROW = WS_ROUTE + 256 * 1024;
constexpr size_t WS_TOPI = 7 * MiB, WS_TOPW = WS_TOPI + 256 * 1024, WS_POS = WS_TOPW + 256 * 1024;
constexpr size_t WS_KERN = 8 * MiB;
constexpr size_t WS_LAMT = 10 * MiB;
constexpr size_t WS_E = 13 * MiB;
constexpr size_t WS_ME = 16 * MiB;
constexpr size_t WS_WINT = 32 * MiB;
constexpr size_t WS_GLUT = 40 * MiB;
constexpr size_t WS_WAT = 41 * MiB, WS_WBT = 42 * MiB;
constexpr size_t WS_WOT = 43 * MiB;
constexpr size_t WS_W1T = 48 * MiB;
constexpr size_t WS_W2T = 176 * MiB;
constexpr size_t WS_X1 = 240 * MiB;
constexpr size_t WS_H2 = 304 * MiB;
constexpr size_t WS_RX = 336 * MiB;
constexpr size_t WS_RY = 480 * MiB;
constexpr size_t WS_H1 = WS_RY, WS_Z = WS_RY + 32 * MiB, WS_GM = WS_RY + 48 * MiB, WS_OA = WS_RY + 64 * MiB, WS_MB = WS_RY + 80 * MiB, WS_MRG = WS_RY + 112 * MiB;
constexpr size_t WS_END = 624 * MiB;
static_assert((size_t)PADROWS * 1024 * 2 <= 144 * MiB, "act / ys fit their regions");

constexpr int RING_BYTES = 131072;
constexpr int LDSCTL_OFF = RING_BYTES, MISC_OFF = LDSCTL_OFF + 320;
constexpr int LDS_BYTES = 147456;

#define XB_TMO      128
#define XB_XCNT(j)  (256  + 64 * (j))
#define XB_XSUB(j)  (1280 + 64 * (j))
#define XB_XGEN(j)  (2304 + 64 * (j))
#define XB_TOP      3328
#define XB_TOPGEN   3392
#define XCD_BAR_WORDS 3456
#define XB_SPIN_CAP (1u << 18)
__device__ __forceinline__ unsigned xb_ld(unsigned* p)              { return __hip_atomic_load(p, __ATOMIC_RELAXED, __HIP_MEMORY_SCOPE_AGENT); }
__device__ __forceinline__ unsigned xb_add(unsigned* p, unsigned v) { return __hip_atomic_fetch_add(p, v, __ATOMIC_RELAXED, __HIP_MEMORY_SCOPE_AGENT); }
__device__ __forceinline__ unsigned xb_xcc_id() { return (unsigned)__builtin_amdgcn_s_getreg((3 << 11) | 20) & 0xFu; }
#define XB_SPIN(cond, bar) do { unsigned _sp = 0; while (cond) { __builtin_amdgcn_s_sleep(1); \
    if ((++_sp & 255u) == 0u) { if (xb_ld(&(bar)[XB_TMO])) break; if (_sp > XB_SPIN_CAP) { atomicAdd(&(bar)[XB_TMO], 1u); break; } } } } while (0)
struct XcdBarrier { unsigned* bar; unsigned x; volatile LAS unsigned* st; };
__device__ __forceinline__ XcdBarrier xcd_barrier_post(unsigned* bar, volatile LAS unsigned* st) {
    XcdBarrier b; b.bar = bar; b.x = xb_xcc_id(); b.st = st;
    if (threadIdx.x == 0) (void)xb_add(&bar[XB_XCNT(b.x)], 1u);
    return b;
}
__device__ __forceinline__ void xcd_barrier_complete(unsigned* bar, unsigned x, unsigned& nloc, unsigned& nx) {
    const unsigned G = gridDim.x * gridDim.y * gridDim.z;
    unsigned sum, cnt, mine, sp = 0u;
    for (;;) {
        sum = 0u; cnt = 0u; mine = 0u;
#pragma unroll
        for (unsigned j = 0; j < 16; ++j) { const unsigned c = xb_ld(&bar[XB_XCNT(j)]); sum += c; cnt += (c > 0u) ? 1u : 0u; mine = (j == x) ? c : mine; }
        if (sum == G) break;
        __builtin_amdgcn_s_sleep(1);
        if ((++sp & 255u) == 0u) { if (xb_ld(&bar[XB_TMO])) break; if (sp > XB_SPIN_CAP) { atomicAdd(&bar[XB_TMO], 1u); break; } }
    }
    nloc = mine > 0u ? mine : 1u; nx = cnt > 0u ? cnt : 1u;
}
__device__ __forceinline__ void xcd_barrier(const XcdBarrier& b) {
    asm volatile("s_waitcnt vmcnt(0)" ::: "memory");
    __syncthreads();
    if (threadIdx.x == 0) {
        unsigned* bar = b.bar;
        __builtin_amdgcn_s_waitcnt(0);
        unsigned nloc = b.st[0], nx = b.st[1];
        if (nloc == 0u) { xcd_barrier_complete(bar, b.x, nloc, nx); b.st[0] = nloc; b.st[1] = nx; }
        const unsigned old = xb_add(&bar[XB_XSUB(b.x)], 1u);
        const unsigned gen = old / nloc;
        if (old + 1u == (gen + 1u) * nloc) {
            __builtin_amdgcn_fence(__ATOMIC_RELEASE, "agent");
            asm volatile("s_waitcnt vmcnt(0)" ::: "memory");
            const unsigned og = xb_add(&bar[XB_TOP], 1u);
            const unsigned tg = og / nx;
            if (og + 1u == (tg + 1u) * nx) xb_add(&bar[XB_TOPGEN], 1u);
            else XB_SPIN(xb_ld(&bar[XB_TOPGEN]) == tg, bar);
            __builtin_amdgcn_fence(__ATOMIC_ACQUIRE, "agent");
            xb_add(&bar[XB_XGEN(b.x)], 1u);
            asm volatile("s_waitcnt vmcnt(0)" ::: "memory");
        } else {
            XB_SPIN(xb_ld(&bar[XB_XGEN(b.x)]) == gen, bar);
            __builtin_amdgcn_fence(__ATOMIC_ACQUIRE, "agent");
            asm volatile("s_waitcnt vmcnt(0)" ::: "memory");
        }
    }
    __syncthreads();
}

struct Args { const float* in[31]; float* out; unsigned char* ws; int ph_lo, ph_hi, rep, pad; };
struct Frame {
    LAS unsigned char* lds;
    int wave, vcu, G;
};
struct DenseOrder {
    const char* A; const char* Bt; int K, nM, nN, nwg, G, c;
    __device__ __forceinline__ void init(const void* A_, const void* Bt_, int M, int N, int K_, int G_, int c_) { A = (const char*)A_; Bt = (const char*)Bt_; K = K_; nM = M / 256; nN = N / 256; nwg = nM * nN; G = G_; c = c_; }
    __device__ __forceinline__ bool next(int i, pg8::Unit& u) const {
        const long L = (long)i * G + c; if (L >= nwg) return false;
        int wgid = (int)L; { const int q = nwg / 8, r = nwg % 8, xcd = wgid % 8, off = wgid / 8; wgid = (xcd < r ? xcd * (q + 1) : r * (q + 1) + (xcd - r) * q) + off; }
        const int nig = 8 * nN, gid = wgid / nig, fm = gid * 8, gsz = (nM - fm) < 8 ? (nM - fm) : 8;
        u.pm = fm + ((wgid % nig) % gsz); u.pn = (wgid % nig) / gsz; u.aux = 0;
        u.abase = A + (size_t)u.pm * 256 * K * 2; u.b0 = Bt + (size_t)u.pn * 256 * K * 2; u.b1 = u.b0 + (size_t)128 * K * 2; return true;
    }
    static constexpr bool GATHER = false;
    __device__ __forceinline__ void aoff(const pg8::Unit&, const int (&R)[2], const int (&C)[2], unsigned (&va)[2][2]) const {
#pragma unroll
        for (int h = 0; h < 2; ++h)
#pragma unroll
            for (int i = 0; i < 2; ++i) va[h][i] = (unsigned)((h * 128 + R[i]) * K + C[i]) * 2u;
    }
};

__device__ __forceinline__ void p0_transpose_item(const float* W, int K, int N, bf16* WT, LAS float* scr, int item, int lane) {
    const int nblk = N / 32, kb = item / nblk, nb = item % nblk, k0 = 64 * kb, n0 = 32 * nb;
    float wv[32];
#pragma unroll
    for (int i = 0; i < 32; ++i) wv[i] = W[(size_t)(k0 + 2 * i + (lane >> 5)) * N + n0 + (lane & 31)];
#pragma unroll
    for (int i = 0; i < 32; ++i) scr[(2 * i + (lane >> 5)) * 33 + (lane & 31)] = wv[i];
    LDS_WAIT(); asm volatile("" ::: "memory");
    const int c = lane & 7;
#pragma unroll
    for (int j = 0; j < 4; ++j) { const int n = (lane >> 3) + 8 * j; const LAS float* s = scr + (8 * c) * 33 + n;
        v4u o; o.x = pk2(s[0 * 33], s[1 * 33]); o.y = pk2(s[2 * 33], s[3 * 33]); o.z = pk2(s[4 * 33], s[5 * 33]); o.w = pk2(s[6 * 33], s[7 * 33]);
        *(GAS v4u*)(WT + (size_t)(n0 + n) * K + k0 + 8 * c) = o; }
    LDS_WAIT(); asm volatile("" ::: "memory");
}
__device__ __forceinline__ void p0_s5_item(const Args& A, unsigned char* ws, LAS float* scr, int item, int lane) {
    const int g = item / 129, tau = item % 129, p = lane;
    const float* a_re = A.in[6]; const float* a_im = A.in[7]; const float* log_dt = A.in[8]; const float* b_re = A.in[9]; const float* b_im = A.in[10]; const float* c_re = A.in[11]; const float* c_im = A.in[12];
    if (tau < 128) {
#pragma unroll
        for (int i = 0; i < 4; ++i) { *(LAS f32x4*)(scr + 2048 + (lane + 64 * i) * 4) = ((const GAS f32x4*)(c_re + (size_t)g * NHC * NP))[lane + 64 * i]; *(LAS f32x4*)(scr + 3072 + (lane + 64 * i) * 4) = ((const GAS f32x4*)(c_im + (size_t)g * NHC * NP))[lane + 64 * i]; }
    }
    const double dt = exp((double)log_dt[g]);
    const double lr = a_re[g * NP + p], li = a_im[g * NP + p];
    const double mg = exp(lr * dt * (double)tau), an = li * dt * (double)tau;
    const float ltr = (float)(mg * cos(an)), lti = (float)(mg * sin(an));
    ((GAS f32x2*)(ws + WS_LAMT))[(size_t)(g * 129 + tau) * NP + p] = (f32x2){ltr, lti};
    if (tau == 128) return;
    const double m1 = exp(lr * dt), lbr = m1 * cos(li * dt), lbi = m1 * sin(li * dt);
    const double nr = lbr - 1.0, ni = lbi, den = lr * lr + li * li;
    const float cfr = (float)((nr * lr + ni * li) / den), cfi = (float)((ni * lr - nr * li) / den);
    const float wr_ = ltr * cfr - lti * cfi, wi_ = ltr * cfi + lti * cfr;
    const f32x4* brp = (const f32x4*)(b_re + (size_t)(g * NP + p) * NHC); const f32x4* bip = (const f32x4*)(b_im + (size_t)(g * NP + p) * NHC);
    unsigned mre[8], mim[8];
#pragma unroll
    for (int q = 0; q < 4; ++q) { const f32x4 br = brp[q], bi = bip[q]; float vr[4], vi[4];
#pragma unroll
        for (int j = 0; j < 4; ++j) { vr[j] = wr_ * br[j] - wi_ * bi[j]; vi[j] = wr_ * bi[j] + wi_ * br[j]; scr[(p * 16 + q * 4 + j) * 2] = vr[j]; scr[(p * 16 + q * 4 + j) * 2 + 1] = vi[j]; }
        mre[2 * q] = pk2(vr[0], vr[1]); mre[2 * q + 1] = pk2(vr[2], vr[3]); mim[2 * q] = pk2(vi[0], vi[1]); mim[2 * q + 1] = pk2(vi[2], vi[3]); }
    { GAS v4u* o = (GAS v4u*)((bf16*)(ws + WS_ME) + ((size_t)(g * 128 + 2 * p) * 2048 + (127 - tau) * 16));
      o[0] = (v4u){mre[0], mre[1], mre[2], mre[3]}; o[1] = (v4u){mre[4], mre[5], mre[6], mre[7]};
      GAS v4u* o2 = (GAS v4u*)((bf16*)(ws + WS_ME) + ((size_t)(g * 128 + 2 * p + 1) * 2048 + (127 - tau) * 16));
      o2[0] = (v4u){mim[0], mim[1], mim[2], mim[3]}; o2[1] = (v4u){mim[4], mim[5], mim[6], mim[7]}; }
    LDS_WAIT(); asm volatile("" ::: "memory");
    const int ho = lane >> 2, hi0 = 4 * (lane & 3);
    const LAS float* crp = scr + 2048 + ho * NP; const LAS float* cip = scr + 3072 + ho * NP;
    float kk[4] = {0.f, 0.f, 0.f, 0.f};
#pragma unroll 8
    for (int pp = 0; pp < NP; ++pp) { const float cr = crp[pp], ci = cip[pp];
#pragma unroll
        for (int j = 0; j < 4; ++j) { const f32x2 w = *(const LAS f32x2*)(scr + (pp * 16 + hi0 + j) * 2); kk[j] += cr * w.x - ci * w.y; } }
    *(GAS v2u*)((bf16*)(ws + WS_KERN) + ((size_t)(g * 128 + tau) * 256 + ho * 16 + hi0)) = (v2u){pk2(kk[0], kk[1]), pk2(kk[2], kk[3])};
    LDS_WAIT(); asm volatile("" ::: "memory");
}
__device__ __forceinline__ void p0_mod_block_item(const Args& A, unsigned char* ws, LAS unsigned char* lds, int wave, int item) {
    const float* c = A.in[1]; const float* ada_w = A.in[2]; const float* ada_b = A.in[3];
    const int lane = (int)threadIdx.x & 63, j = item * 64 + lane;
    LAS float* scr = (LAS float*)(lds + wave * 16384);
    for (int i = lane; i < 8 * 128; i += 64) { const int b = i >> 7, k = i & 127; const float cv = c[b * D + wave * 128 + k]; scr[k * 8 + b] = cv / (1.f + __expf(-cv)); }
    LDS_WAIT(); asm volatile("" ::: "memory");
    float acc[8] = {0.f, 0.f, 0.f, 0.f, 0.f, 0.f, 0.f, 0.f};
    const float* wp = ada_w + (size_t)(wave * 128) * (NMOD * D) + j;
#pragma unroll 1
    for (int k0 = 0; k0 < 128; k0 += 16) { float wv[16];
#pragma unroll
        for (int q = 0; q < 16; ++q) wv[q] = wp[(size_t)(k0 + q) * (NMOD * D)];
#pragma unroll
        for (int q = 0; q < 16; ++q) { const f32x4 s0 = *(const LAS f32x4*)(scr + (k0 + q) * 8), s1 = *(const LAS f32x4*)(scr + (k0 + q) * 8 + 4);
            acc[0] += s0[0] * wv[q]; acc[1] += s0[1] * wv[q]; acc[2] += s0[2] * wv[q]; acc[3] += s0[3] * wv[q]; acc[4] += s1[0] * wv[q]; acc[5] += s1[1] * wv[q]; acc[6] += s1[2] * wv[q]; acc[7] += s1[3] * wv[q]; } }
    LDS_WAIT(); __syncthreads();
    LAS float* red = (LAS float*)lds;
#pragma unroll
    for (int b = 0; b < 8; ++b) red[(wave * 8 + b) * 64 + lane] = acc[b];
    LDS_WAIT(); __syncthreads();
    { float v = ada_b[j];
#pragma unroll
      for (int w2 = 0; w2 < 8; ++w2) v += red[(w2 * 8 + wave) * 64 + lane];
      ((float*)(ws + WS_MOD))[wave * (NMOD * D) + j] = v; }
    LDS_WAIT(); __syncthreads();
}
constexpr int MOE_I1 = (D / 64) * (2 * DE / 32), MOE_I2 = (DE / 64) * (D / 32), MOE_ITEMS = NE * MOE_I1 + NE * MOE_I2;
constexpr int MOE_ITEMS_P2 = 8192, MOE_ITEMS_P5 = 4096, MOE_ITEMS_P0 = MOE_ITEMS - MOE_ITEMS_P2 - MOE_ITEMS_P5;
__device__ __forceinline__ void moe_transpose_item(const Args& A, unsigned char* ws, LAS float* scr, int r, int lane) {
    if (r < NE * MOE_I1) { const int e = r / MOE_I1; p0_transpose_item(A.in[26] + (size_t)e * D * 2 * DE, D, 2 * DE, (bf16*)(ws + WS_W1T) + (size_t)e * 2 * DE * D, scr, r % MOE_I1, lane); }
    else { r -= NE * MOE_I1; const int e = r / MOE_I2; p0_transpose_item(A.in[28] + (size_t)e * DE * D, DE, D, (bf16*)(ws + WS_W2T) + (size_t)e * D * DE, scr, r % MOE_I2, lane); }
}
__device__ __forceinline__ void moe_filler(const Args& A, const Frame& F, int idle_idx, int n_idle, int lo, int hi) {
    LAS float* scr = (LAS float*)(F.lds + F.wave * 16384);
    for (int it = lo + idle_idx * NWAVES + F.wave; it < hi; it += n_idle * NWAVES) moe_transpose_item(A, A.ws, scr, it, ((int)threadIdx.x & 63));
}
__device__ __forceinline__ void p0_prologue(const Args& A, const Frame& F) {
    unsigned char* ws = A.ws;
    LAS float* scr = (LAS float*)(F.lds + F.wave * 16384);
    const int gw = F.vcu * NWAVES + F.wave, NGW = F.G * NWAVES;
    constexpr int I_S5 = NG * 129, I_MOD = NMOD * D / 64;
    constexpr int I_WIN = (D / 64) * (PW / 32), I_GLU = (SW / 64) * (SW / 32), I_BR = (SW / 64) * (D / 32), I_WO = (D / 64) * (D / 32), I_M1 = (D / 64) * (2 * DE / 32), I_M2 = (DE / 64) * (D / 32);
    constexpr int NITEMS = I_S5 + I_WIN + I_GLU + 2 * I_BR + I_WO + MOE_ITEMS_P0;
    for (int it = F.vcu; it < I_MOD; it += F.G) p0_mod_block_item(A, ws, F.lds, F.wave, it);
    for (int it = gw; it < NITEMS; it += NGW) {
        int r = it;
        if (r < I_S5) { p0_s5_item(A, ws, scr, r, ((int)threadIdx.x & 63)); continue; } r -= I_S5;
        if (r < I_WIN) { p0_transpose_item(A.in[5], D, PW, (bf16*)(ws + WS_WINT), scr, r, ((int)threadIdx.x & 63)); continue; } r -= I_WIN;
        if (r < I_GLU) { p0_transpose_item(A.in[14], SW, SW, (bf16*)(ws + WS_GLUT), scr, r, ((int)threadIdx.x & 63)); continue; } r -= I_GLU;
        if (r < I_BR) { p0_transpose_item(A.in[16], SW, D, (bf16*)(ws + WS_WAT), scr, r, ((int)threadIdx.x & 63)); continue; } r -= I_BR;
        if (r < I_BR) { p0_transpose_item(A.in[21], SW, D, (bf16*)(ws + WS_WBT), scr, r, ((int)threadIdx.x & 63)); continue; } r -= I_BR;
        if (r < I_WO) { p0_transpose_item(A.in[22], D, D, (bf16*)(ws + WS_WOT), scr, r, ((int)threadIdx.x & 63)); continue; } r -= I_WO;
        moe_transpose_item(A, ws, scr, r, ((int)threadIdx.x & 63));
    }
    const int gt = F.vcu * NTHREADS + ((int)threadIdx.x), NGT = F.G * NTHREADS;
    for (int i = gt; i < NG * NHC * 128; i += NGT) { const int k = i & 127, ho = (i >> 7) & 15, g = i >> 11, p = k >> 1;
        const float v = (k & 1) ? -A.in[12][(size_t)(g * NHC + ho) * NP + p] : A.in[11][(size_t)(g * NHC + ho) * NP + p]; ((bf16*)(ws + WS_CMT))[i] = (bf16)f2bf(v); }
    for (int i = gt; i < NHEAD * CHUNK * CHUNK; i += NGT) { const int s = i & 127, t = (i >> 7) & 127; ((bf16*)(ws + WS_WSM))[i] = (s <= t) ? (bf16)f2bf(A.in[19][i]) : (bf16)0; }
    for (int i = gt; i < D * NE; i += NGT) { const int e = i & 31, k = i >> 5; const float v = A.in[24][i]; const unsigned hi = f2bf(v); const float lo = v - bf2f((unsigned short)hi);
        ((bf16*)(ws + WS_RWT))[e * D + k] = (bf16)hi; ((bf16*)(ws + WS_RWT))[NE * D + e * D + k] = (bf16)f2bf(lo); }
}

__device__ __forceinline__ void norm_mod_row_bf16(const float* xrow, const float* g, const float* shift, const float* scale, bf16* orow, int lane) {
    const GAS f32x4* xr = (const GAS f32x4*)xrow + lane;
    f32x4 v[4]; float s = 0.f;
#pragma unroll
    for (int j = 0; j < 4; ++j) { v[j] = xr[64 * j]; s += (v[j].x * v[j].x + v[j].y * v[j].y) + (v[j].z * v[j].z + v[j].w * v[j].w); }
    const float r = rsqrtf(wave_sum(s) * (1.f / D) + EPS);
    GAS v2u* o8 = (GAS v2u*)orow + lane;
#pragma unroll
    for (int j = 0; j < 4; ++j) { const f32x4 gg = ((const GAS f32x4*)g)[lane + 64 * j], sh = ((const GAS f32x4*)shift)[lane + 64 * j], sc = ((const GAS f32x4*)scale)[lane + 64 * j];
        const f32x4 o = v[j] * r * gg * (sc + 1.f) + sh; o8[64 * j] = (v2u){pk2(o.x, o.y), pk2(o.z, o.w)}; }
}
__device__ __forceinline__ void p1_h1(const Args& A, const Frame& F) {
    const int gw = F.vcu * NWAVES + F.wave, NGW = F.G * NWAVES;
    const float* mod = (const float*)(A.ws + WS_MOD);
    for (int m = gw; m < T; m += NGW) { const int b = m / SEQ;
        norm_mod_row_bf16(A.in[0] + (size_t)m * D, A.in[4], mod + b * (NMOD * D), mod + b * (NMOD * D) + D, (bf16*)(A.ws + WS_H1) + (size_t)m * D, ((int)threadIdx.x & 63)); }
}

struct EpiProj {
    static constexpr bool PERM = true;
    bf16* O;
    __device__ __forceinline__ void operator()(const pg8::f32x4 (&acc)[2][2][4][2], const pg8::Unit& u, int wr, int wc, int fr, int fq) const {
        const int row0 = u.pm * 256 + wr * 64 + fr, col0 = u.pn * 256 + wc * 32 + 8 * fq;
        const int mode = u.pn < 2 ? 0 : (u.pn < 6 ? 1 : 2);
#pragma unroll
        for (int ai = 0; ai < 2; ++ai)
#pragma unroll
            for (int m = 0; m < 4; ++m) { bf16* rowp = O + (size_t)(row0 + ai * 128 + m * 16) * PW + col0;
#pragma unroll
                for (int bj = 0; bj < 2; ++bj) { float v[8];
#pragma unroll
                    for (int j = 0; j < 4; ++j) { v[j] = acc[ai][bj][m][0][j]; v[4 + j] = acc[ai][bj][m][1][j]; }
                    if (mode == 1) {
#pragma unroll
                        for (int j = 0; j < 8; ++j) v[j] = gelu_t(v[j]); }
                    else if (mode == 2) {
#pragma unroll
                        for (int j = 0; j < 8; ++j) v[j] = sigm(v[j]); }
                    *(v4u*)(rowp + bj * 128) = (v4u){pk2(v[0], v[1]), pk2(v[2], v[3]), pk2(v[4], v[5]), pk2(v[6], v[7])}; } }
    }
};
__device__ __forceinline__ void p2_proj(const Args& A, const Frame& F) {
    DenseOrder S; S.init(A.ws + WS_H1, A.ws + WS_WINT, T, PW, D, F.G, (int)blockIdx.x);
    EpiProj E{(bf16*)(A.ws + WS_RX)};
    pg8::gemm_phase<EpiProj, DenseOrder>(F.lds, D, S, E);
    { const int nwg = (T / 256) * (PW / 256), rem = nwg % F.G, c = (int)blockIdx.x;
      if (rem == 0) { moe_filler(A, F, c, F.G, MOE_ITEMS_P0, MOE_ITEMS_P0 + MOE_ITEMS_P2); }
      else if (c >= rem) moe_filler(A, F, c - rem, F.G - rem, MOE_ITEMS_P0, MOE_ITEMS_P0 + MOE_ITEMS_P2); }
}
__device__ __forceinline__ void p3_epass_unit(const Args& A, const Frame& F, int unit) {
    const int b = unit >> 5, g = unit & 31, tid = (int)threadIdx.x, lane = tid & 63, m = lane & 15, kq = lane >> 4;
    const bf16* PA = (const bf16*)(A.ws + WS_RX);
#pragma unroll
    for (int i = 0; i < 8; ++i) { const int id = tid + 512 * i, tok = id >> 1, half = id & 1;
        *(LAS v4u*)(F.lds + (tok >> 7) * 4112 + (tok & 127) * 32 + half * 16) = *(const GAS v4u*)(PA + (size_t)(b * SEQ + tok) * PW + g * NHC + 8 * half); }
    LDS_WAIT(); __syncthreads();
    const LAS unsigned char* ua = F.lds + m * 4112 + (kq >> 1) * 32 + (kq & 1) * 16;
    const bf16* mb = (const bf16*)(A.ws + WS_ME) + ((size_t)(g * 128 + F.wave * 16 + m) * 2048 + 8 * kq);
    f32x4 acc = {0.f, 0.f, 0.f, 0.f};
#pragma unroll 1
    for (int k0 = 0; k0 < 64; k0 += 16) {
        bf16x8 bfr[16];
#pragma unroll
        for (int j = 0; j < 16; ++j) bfr[j] = *(const GAS bf16x8*)(mb + 32 * (k0 + j));
#pragma unroll
        for (int j = 0; j < 16; ++j) { const bf16x8 af = *(const LAS bf16x8*)(ua + (k0 + j) * 64); acc = __builtin_amdgcn_mfma_f32_16x16x32_bf16(bfr[j], af, acc, 0, 0, 0); }
    }
    *(GAS f32x4*)((float*)(A.ws + WS_E) + ((size_t)((b * NCH + m) * NG + g) * 128 + F.wave * 16 + 4 * kq)) = acc;
    __syncthreads();
}

constexpr int VNT_STRIDE = 272;
__device__ __forceinline__ void p3_gmlp_unit(const Args& A, const Frame& F, int unit) {
    const int chunk = unit >> 1, hh = unit & 1, lane = ((int)threadIdx.x & 63), w = F.wave;
    const bf16* PA = (const bf16*)(A.ws + WS_RX);
    const float* lng = A.in[17]; const float* lnb = A.in[18];
    const f32x4 g0 = *(const GAS f32x4*)(lng + 8 * lane), g1 = *(const GAS f32x4*)(lng + 8 * lane + 4), b0 = *(const GAS f32x4*)(lnb + 8 * lane), b1 = *(const GAS f32x4*)(lnb + 8 * lane + 4);
#pragma unroll 4
    for (int i = 0; i < 16; ++i) {
        const int s = 16 * w + i;
        const v4u raw = *(const GAS v4u*)(PA + (size_t)(chunk * CHUNK + s) * PW + 2 * GW + 8 * lane);
        float v[8] = {bflo(raw.x), bfhi(raw.x), bflo(raw.y), bfhi(raw.y), bflo(raw.z), bfhi(raw.z), bflo(raw.w), bfhi(raw.w)};
        float sm = 0.f, sq = 0.f;
#pragma unroll
        for (int j = 0; j < 8; ++j) { sm += v[j]; sq += v[j] * v[j]; }
#pragma unroll
        for (int o = 1; o < 64; o <<= 1) { sm += __shfl_xor(sm, o); sq += __shfl_xor(sq, o); }
        const float mu = sm * (1.f / GW);
        const float r = rsqrtf(fmaxf(sq * (1.f / GW) - mu * mu, 0.f) + EPS);
#pragma unroll
        for (int j = 0; j < 8; ++j) v[j] -= mu;
        if ((lane >> 5) == hh) {
            LAS unsigned char* dst = F.lds + (8 * (lane & 31)) * VNT_STRIDE + (((s >> 3) ^ (lane & 15)) << 4) + 2 * (s & 7);
#pragma unroll
            for (int j = 0; j < 8; ++j) { const float o = v[j] * r * (j < 4 ? g0[j & 3] : g1[j & 3]) + (j < 4 ? b0[j & 3] : b1[j & 3]); *(LAS unsigned short*)(dst + j * VNT_STRIDE) = (unsigned short)f2bf(o); }
        }
    }
    LDS_WAIT(); __syncthreads();
    const int hl = w >> 1, th = w & 1, h = 4 * hh + hl, fr = lane & 15, kq = lane >> 4;
    const bf16* wsm = (const bf16*)(A.ws + WS_WSM) + (size_t)h * CHUNK * CHUNK;
    f32x4 acc[4][4];
#pragma unroll
    for (int cb = 0; cb < 4; ++cb)
#pragma unroll
        for (int tb = 0; tb < 4; ++tb) acc[cb][tb] = (f32x4){0.f, 0.f, 0.f, 0.f};
    const int kmax = th ? 4 : 2;
    for (int kk = 0; kk < kmax; ++kk) {
        bf16x8 vf[4], wf[4];
#pragma unroll
        for (int cb = 0; cb < 4; ++cb) { const int row = 64 * hl + 16 * cb + fr; vf[cb] = *(const LAS bf16x8*)(F.lds + row * VNT_STRIDE + (((4 * kk + kq) ^ ((row >> 3) & 15)) << 4)); }
#pragma unroll
        for (int tb = 0; tb < 4; ++tb) wf[tb] = *(const GAS bf16x8*)(wsm + (size_t)(64 * th + 16 * tb + fr) * CHUNK + 32 * kk + 8 * kq);
#pragma unroll
        for (int cb = 0; cb < 4; ++cb)
#pragma unroll
            for (int tb = 0; tb < 4; ++tb) acc[cb][tb] = __builtin_amdgcn_mfma_f32_16x16x32_bf16(vf[cb], wf[tb], acc[cb][tb], 0, 0, 0);
    }
    const float* bs = A.in[20] + h * CHUNK;
    bf16* GM = (bf16*)(A.ws + WS_GM);
#pragma unroll
    for (int tb = 0; tb < 4; ++tb) { const int t = 64 * th + 16 * tb + fr; const float bias = bs[t]; const size_t row = (size_t)(chunk * CHUNK + t);
#pragma unroll
        for (int cb = 0; cb < 4; ++cb) { const int cg = 256 * hh + 64 * hl + 16 * cb + 4 * kq;
            const v2u gu = *(const GAS v2u*)(PA + row * PW + GW + cg);
            const float o0 = bflo(gu.x) * (acc[cb][tb][0] + bias), o1 = bfhi(gu.x) * (acc[cb][tb][1] + bias), o2 = bflo(gu.y) * (acc[cb][tb][2] + bias), o3 = bfhi(gu.y) * (acc[cb][tb][3] + bias);
            *(GAS v2u*)(GM + row * GW + cg) = (v2u){pk2(o0, o1), pk2(o2, o3)}; } }
    __syncthreads();
}
__device__ __forceinline__ void p3_phase(const Args& A, const Frame& F) {
    for (int u = F.vcu; u < NB * NG + 2 * (T / CHUNK); u += F.G) { if (u < NB * NG) p3_epass_unit(A, F, u); else p3_gmlp_unit(A, F, u - NB * NG); }
}

constexpr int Y_KERN = 0, Y_UT = 65536, Y_UTW = 4608, Y_CMT = Y_UT + 8 * Y_UTW, Y_CMT_STRIDE = 272, Y_XS = Y_CMT + 16 * Y_CMT_STRIDE, Y_END = Y_XS + 8 * 512;
static_assert(Y_END <= RING_BYTES, "Y-pass LDS map");
__device__ __forceinline__ void p4_ypass_unit(const Args& A, const Frame& F, int unit, bool load_tables) {
    int lane = ((int)threadIdx.x & 63), tid = ((int)threadIdx.x); asm volatile("" : "+v"(lane), "+v"(tid));
    const int g = unit >> 4, o = unit & 15, w = F.wave, gc = 8 * o + w, b = gc >> 4, c = gc & 15;
    int fr = lane & 15, kq = lane >> 4;
    const bf16* PA = (const bf16*)(A.ws + WS_RX);
    LAS unsigned char* lds = F.lds;
    if (load_tables) {
      const GAS v4u* src = (const GAS v4u*)(A.ws + WS_KERN + (size_t)g * 65536);
#pragma unroll
      for (int i = 0; i < 8; ++i) *(LAS v4u*)(lds + Y_KERN + (tid + 512 * i) * 16) = src[tid + 512 * i];
      if (tid < 256) { const int ho = tid >> 4, ch = tid & 15; *(LAS v4u*)(lds + Y_CMT + ho * Y_CMT_STRIDE + ch * 16) = *(const GAS v4u*)(A.ws + WS_CMT + (size_t)(g * NHC + ho) * 256 + ch * 16); }
    }
    LAS unsigned char* ut = lds + Y_UT + w * Y_UTW;
#pragma unroll
    for (int i = 0; i < 4; ++i) { const int id = lane + 64 * i, s = id >> 1, half = id & 1;
        *(LAS v4u*)(ut + half * 2304 + (16 + s) * 16) = *(const GAS v4u*)(PA + (size_t)(gc * CHUNK + s) * PW + g * NHC + 8 * half); }
    if (lane < 32) *(LAS v4u*)(ut + (lane >> 4) * 2304 + (lane & 15) * 16) = (v4u){0u, 0u, 0u, 0u};
    { const f32x2 l128 = ((const GAS f32x2*)(A.ws + WS_LAMT))[(size_t)(g * 129 + 128) * NP + lane];
      const GAS f32x2* ep = (const GAS f32x2*)((const float*)(A.ws + WS_E) + ((size_t)(b * NCH) * NG + g) * 128) + lane;
      float xr = 0.f, xi = 0.f; f32x2 ev[15];
#pragma unroll
      for (int cp = 0; cp < 15; ++cp) ev[cp] = ep[(size_t)cp * NG * 64];
#pragma unroll
      for (int cp = 0; cp < 15; ++cp) if (cp < c) { const float nr = l128.x * xr - l128.y * xi + ev[cp].x, ni = l128.x * xi + l128.y * xr + ev[cp].y; xr = nr; xi = ni; }
      *(LAS f32x2*)(lds + Y_XS + w * 512 + lane * 8) = (f32x2){xr, xi}; }
    LDS_WAIT(); __syncthreads();
    asm volatile("" : "+v"(lane)); fr = lane & 15; kq = lane >> 4;
    f32x4 acc[8];
#pragma unroll
    for (int i = 0; i < 8; ++i) acc[i] = (f32x4){0.f, 0.f, 0.f, 0.f};
    const LAS unsigned char* kbase = lds + Y_KERN + (kq >> 1) * 512 + fr * 32 + (kq & 1) * 16;
    const LAS unsigned char* ubase = ut + (kq & 1) * 2304 + (16 + fr - (kq >> 1)) * 16;
#define Y_LD6(F, q_) do { F[0] = *(const LAS bf16x8*)(kbase + (q_) * 1024); F[1] = *(const LAS bf16x8*)(kbase + (q_) * 1024 + 1024); \
        F[2] = *(const LAS bf16x8*)(ub0 - (q_) * 32); F[3] = *(const LAS bf16x8*)(ub0 - (q_) * 32 - 32); F[4] = *(const LAS bf16x8*)(ub0 + 256 - (q_) * 32); F[5] = *(const LAS bf16x8*)(ub0 + 256 - (q_) * 32 - 32); } while (0)
#define Y_MM4(F, a0, a1) do { a0 = __builtin_amdgcn_mfma_f32_16x16x32_bf16(F[0], F[2], a0, 0, 0, 0); a1 = __builtin_amdgcn_mfma_f32_16x16x32_bf16(F[0], F[4], a1, 0, 0, 0); \
        a0 = __builtin_amdgcn_mfma_f32_16x16x32_bf16(F[1], F[3], a0, 0, 0, 0); a1 = __builtin_amdgcn_mfma_f32_16x16x32_bf16(F[1], F[5], a1, 0, 0, 0); } while (0)
#define Y_MM2(F, a1) do { a1 = __builtin_amdgcn_mfma_f32_16x16x32_bf16(F[0], F[4], a1, 0, 0, 0); a1 = __builtin_amdgcn_mfma_f32_16x16x32_bf16(F[1], F[5], a1, 0, 0, 0); } while (0)
#pragma unroll
    for (int j = 0; j < 4; ++j) {
        const LAS unsigned char* ub0 = ubase + (32 * j) * 16;
        bf16x8 fa[6], fb[6];
        const int qA = 16 * j + 8;
        Y_LD6(fa, 0);
#pragma unroll 1
        for (int q = 0; q < qA; q += 4) { Y_LD6(fb, q + 2); Y_MM4(fa, acc[2 * j], acc[2 * j + 1]); Y_LD6(fa, q + 4); Y_MM4(fb, acc[2 * j], acc[2 * j + 1]); }
#pragma unroll 1
        for (int q = qA; q < qA + 8; q += 4) { Y_LD6(fb, q + 2); Y_MM2(fa, acc[2 * j + 1]); Y_LD6(fa, q + 4); Y_MM2(fb, acc[2 * j + 1]); }
    }
#undef Y_LD6
#undef Y_MM4
#undef Y_MM2
    asm volatile("" : "+v"(lane)); fr = lane & 15; kq = lane >> 4;
    {
        bf16x8 cf[4]; float z[4][8], l16[4][8];
#pragma unroll
        for (int kk = 0; kk < 4; ++kk) {
            cf[kk] = *(const LAS bf16x8*)(lds + Y_CMT + fr * Y_CMT_STRIDE + (32 * kk + 8 * kq) * 2);
            const f32x4 x0 = *(const LAS f32x4*)(lds + Y_XS + w * 512 + (16 * kk + 4 * kq) * 8), x1 = *(const LAS f32x4*)(lds + Y_XS + w * 512 + (16 * kk + 4 * kq) * 8 + 16);
            const GAS f32x4* lp = (const GAS f32x4*)((const float*)(A.ws + WS_LAMT) + ((size_t)(g * 129 + fr + 1) * NP + 16 * kk + 4 * kq) * 2);
            const GAS f32x4* lq = (const GAS f32x4*)((const float*)(A.ws + WS_LAMT) + ((size_t)(g * 129 + 16) * NP + 16 * kk + 4 * kq) * 2);
            const f32x4 l0 = lp[0], l1 = lp[1], q0 = lq[0], q1 = lq[1];
            z[kk][0] = l0[0] * x0[0] - l0[1] * x0[1]; z[kk][1] = l0[0] * x0[1] + l0[1] * x0[0]; z[kk][2] = l0[2] * x0[2] - l0[3] * x0[3]; z[kk][3] = l0[2] * x0[3] + l0[3] * x0[2];
            z[kk][4] = l1[0] * x1[0] - l1[1] * x1[1]; z[kk][5] = l1[0] * x1[1] + l1[1] * x1[0]; z[kk][6] = l1[2] * x1[2] - l1[3] * x1[3]; z[kk][7] = l1[2] * x1[3] + l1[3] * x1[2];
#pragma unroll
            for (int j = 0; j < 4; ++j) { l16[kk][j] = q0[j]; l16[kk][4 + j] = q1[j]; }
        }
#pragma unroll
        for (int i = 0; i < 8; ++i) {
#pragma unroll
            for (int kk = 0; kk < 4; ++kk) {
                const v4u zp = (v4u){pk2(z[kk][0], z[kk][1]), pk2(z[kk][2], z[kk][3]), pk2(z[kk][4], z[kk][5]), pk2(z[kk][6], z[kk][7])};
                acc[i] = __builtin_amdgcn_mfma_f32_16x16x32_bf16(cf[kk], __builtin_bit_cast(bf16x8, zp), acc[i], 0, 0, 0);
                if (i < 7) {
#pragma unroll
                    for (int j = 0; j < 4; ++j) { const float zr = z[kk][2 * j], zi = z[kk][2 * j + 1], lr = l16[kk][2 * j], li = l16[kk][2 * j + 1]; z[kk][2 * j] = lr * zr - li * zi; z[kk][2 * j + 1] = lr * zi + li * zr; }
                }
            }
        }
    }
    asm volatile("" : "+v"(lane)); fr = lane & 15; kq = lane >> 4;
    const f32x4 dsk = *(const GAS f32x4*)(A.in[13] + g * NHC + 4 * kq);
    bf16* Z = (bf16*)(A.ws + WS_Z);
#pragma unroll
    for (int i = 0; i < 8; ++i) { const int t = 16 * i + fr;
        const v2u uu = *(const LAS v2u*)(ut + (kq >> 1) * 2304 + (16 + t) * 16 + (kq & 1) * 8);
        const float y0 = acc[i][0] + dsk[0] * bflo(uu.x), y1 = acc[i][1] + dsk[1] * bfhi(uu.x), y2 = acc[i][2] + dsk[2] * bflo(uu.y), y3 = acc[i][3] + dsk[3] * bfhi(uu.y);
        *(GAS v2u*)(Z + (size_t)(gc * CHUNK + t) * SW + g * NHC + 4 * kq) = (v2u){pk2(gelu_t(y0), gelu_t(y1)), pk2(gelu_t(y2), gelu_t(y3))}; }
    __syncthreads();
}
__device__ __forceinline__ void p4_phase(const Args& A, const Frame& F) {
    int prev_g = -1;
    for (int u0 = 2 * F.vcu; u0 < NG * (T / CHUNK / 8); u0 += 2 * F.G)
        for (int r = 0; r < 2; ++r) { const int u = u0 + r; p4_ypass_unit(A, F, u, (u >> 4) != prev_g); prev_g = u >> 4; }
}
struct P5Order {
    const char *GM, *WBT, *Z, *GLUT; int G, c;
    __device__ __forceinline__ bool next(int i, pg8::Unit& u) const {
        const long L = (long)i * G + c; if (L >= 384) return false;
        const bool glu = L >= 256; int wgid = glu ? (int)L - 256 : (int)L; const int nN = glu ? 2 : 4, nwg = 64 * nN;
        { const int q = nwg / 8, xcd = wgid % 8, off = wgid / 8; wgid = xcd * q + off; }
        const int nig = 8 * nN, gid = wgid / nig, fm = gid * 8;
        u.pm = fm + ((wgid % nig) % 8); u.pn = (wgid % nig) / 8; u.aux = glu ? 1 : 0;
        u.abase = (glu ? Z : GM) + (size_t)u.pm * 256 * SW * 2; u.b0 = (glu ? GLUT : WBT) + (size_t)u.pn * 256 * SW * 2; u.b1 = u.b0 + (size_t)128 * SW * 2; return true;
    }
    static constexpr bool GATHER = false;
    __device__ __forceinline__ void aoff(const pg8::Unit&, const int (&R)[2], const int (&C)[2], unsigned (&va)[2][2]) const {
#pragma unroll
        for (int h = 0; h < 2; ++h)
#pragma unroll
            for (int i = 0; i < 2; ++i) va[h][i] = (unsigned)((h * 128 + R[i]) * SW + C[i]) * 2u;
    }
};
struct EpiP5 {
    static constexpr bool PERM = true;
    const bf16* PA; const bf16* Z; const float* glu_b; bf16* MB; bf16* OA;
    __device__ __forceinline__ void operator()(const pg8::f32x4 (&acc)[2][2][4][2], const pg8::Unit& u, int wr, int wc, int fr, int fq) const {
        const int row0 = u.pm * 256 + wr * 64 + fr, col0 = u.pn * 256 + wc * 32 + 8 * fq;
        if (u.aux == 0) {
#pragma unroll
            for (int ai = 0; ai < 2; ++ai)
#pragma unroll
                for (int m = 0; m < 4; ++m) { const size_t row = (size_t)(row0 + ai * 128 + m * 16);
#pragma unroll
                    for (int bj = 0; bj < 2; ++bj) { const int col = col0 + bj * 128;
                        const v4u s = *(const GAS v4u*)(PA + row * PW + (SW + 2 * GW + D) + col);
                        const pg8::f32x4 a0 = acc[ai][bj][m][0], a1 = acc[ai][bj][m][1];
                        *(GAS v4u*)(MB + row * D + col) = (v4u){pk2(bflo(s.x) * a0[0], bfhi(s.x) * a0[1]), pk2(bflo(s.y) * a0[2], bfhi(s.y) * a0[3]), pk2(bflo(s.z) * a1[0], bfhi(s.z) * a1[1]), pk2(bflo(s.w) * a1[2], bfhi(s.w) * a1[3])}; } }
        } else {
#pragma unroll
            for (int bj = 0; bj < 2; ++bj) { const int col = col0 + bj * 128;
                const f32x4 b0 = *(const GAS f32x4*)(glu_b + col), b1 = *(const GAS f32x4*)(glu_b + col + 4);
#pragma unroll
                for (int ai = 0; ai < 2; ++ai)
#pragma unroll
                    for (int m = 0; m < 4; ++m) { const size_t row = (size_t)(row0 + ai * 128 + m * 16);
                        const v4u s = *(const GAS v4u*)(Z + row * SW + col);
                        const pg8::f32x4 a0 = acc[ai][bj][m][0], a1 = acc[ai][bj][m][1];
                        *(GAS v4u*)(OA + row * SW + col) = (v4u){pk2(bflo(s.x) * sigm(a0[0] + b0[0]), bfhi(s.x) * sigm(a0[1] + b0[1])), pk2(bflo(s.y) * sigm(a0[2] + b0[2]), bfhi(s.y) * sigm(a0[3] + b0[3])),
                                                                   pk2(bflo(s.z) * sigm(a1[0] + b1[0]), bfhi(s.z) * sigm(a1[1] + b1[1])), pk2(bflo(s.w) * sigm(a1[2] + b1[2]), bfhi(s.w) * sigm(a1[3] + b1[3]))}; } }
        }
    }
};
__device__ __forceinline__ void p5_phase(const Args& A, const Frame& F) {
    P5Order S{(const char*)(A.ws + WS_GM), (const char*)(A.ws + WS_WBT), (const char*)(A.ws + WS_Z), (const char*)(A.ws + WS_GLUT), F.G, (int)blockIdx.x};
    EpiP5 E{(const bf16*)(A.ws + WS_RX), (const bf16*)(A.ws + WS_Z), A.in[15], (bf16*)(A.ws + WS_MB), (bf16*)(A.ws + WS_OA)};
    pg8::gemm_phase<EpiP5, P5Order>(F.lds, SW, S, E);
    { const int rem = 384 % F.G, c = (int)blockIdx.x;
      if (rem == 0) { moe_filler(A, F, c, F.G, MOE_ITEMS_P0 + MOE_ITEMS_P2, MOE_ITEMS); }
      else if (c >= rem) moe_filler(A, F, c - rem, F.G - rem, MOE_ITEMS_P0 + MOE_ITEMS_P2, MOE_ITEMS); }
}
struct EpiP6 {
    static constexpr bool PERM = true;
    const bf16* PA; const bf16* MB; bf16* MRG;
    __device__ __forceinline__ void operator()(const pg8::f32x4 (&acc)[2][2][4][2], const pg8::Unit& u, int wr, int wc, int fr, int fq) const {
        const int row0 = u.pm * 256 + wr * 64 + fr, col0 = u.pn * 256 + wc * 32 + 8 * fq;
#pragma unroll
        for (int ai = 0; ai < 2; ++ai)
#pragma unroll
            for (int m = 0; m < 4; ++m) { const size_t row = (size_t)(row0 + ai * 128 + m * 16);
#pragma unroll
                for (int bj = 0; bj < 2; ++bj) { const int col = col0 + bj * 128;
                    const v4u s = *(const GAS v4u*)(PA + row * PW + (SW + 2 * GW) + col); const v4u q = *(const GAS v4u*)(MB + row * D + col);
                    const pg8::f32x4 a0 = acc[ai][bj][m][0], a1 = acc[ai][bj][m][1];
                    *(GAS v4u*)(MRG + row * D + col) = (v4u){pk2(bflo(s.x) * a0[0] + bflo(q.x), bfhi(s.x) * a0[1] + bfhi(q.x)), pk2(bflo(s.y) * a0[2] + bflo(q.y), bfhi(s.y) * a0[3] + bfhi(q.y)),
                                                            pk2(bflo(s.z) * a1[0] + bflo(q.z), bfhi(s.z) * a1[1] + bfhi(q.z)), pk2(bflo(s.w) * a1[2] + bflo(q.w), bfhi(s.w) * a1[3] + bfhi(q.w))}; } }
    }
};
__device__ __forceinline__ void p6_phase(const Args& A, const Frame& F) {
    DenseOrder S; S.init(A.ws + WS_OA, A.ws + WS_WAT, T, D, SW, F.G, (int)blockIdx.x);
    EpiP6 E{(const bf16*)(A.ws + WS_RX), (const bf16*)(A.ws + WS_MB), (bf16*)(A.ws + WS_MRG)};
    pg8::gemm_phase<EpiP6, DenseOrder>(F.lds, SW, S, E);
}
struct EpiP7 {
    static constexpr bool PERM = false;
    const float* x; const float* mod; float* X1;
    __device__ __forceinline__ void operator()(const pg8::f32x4 (&acc)[2][2][4][2], const pg8::Unit& u, int wr, int wc, int fr, int fq) const {
        const int row0 = u.pm * 256 + wr * 64 + fr, col0 = u.pn * 256 + wc * 32 + 4 * fq;
        const float* g1 = mod + ((u.pm * 256) / SEQ) * (NMOD * D) + 2 * D;
        f32x4 gv[2][2];
#pragma unroll
        for (int bj = 0; bj < 2; ++bj)
#pragma unroll
            for (int n = 0; n < 2; ++n) gv[bj][n] = *(const GAS f32x4*)(g1 + col0 + bj * 128 + n * 16);
#pragma unroll
        for (int ai = 0; ai < 2; ++ai)
#pragma unroll
            for (int m = 0; m < 4; ++m) { const size_t off = (size_t)(row0 + ai * 128 + m * 16) * D + col0;
#pragma unroll
                for (int bj = 0; bj < 2; ++bj)
#pragma unroll
                    for (int n = 0; n < 2; ++n) { const f32x4 xv = *(const GAS f32x4*)(x + off + bj * 128 + n * 16); *(GAS f32x4*)(X1 + off + bj * 128 + n * 16) = xv + gv[bj][n] * acc[ai][bj][m][n]; } }
    }
};
__device__ __forceinline__ void p7_phase(const Args& A, const Frame& F) {
    DenseOrder S; S.init(A.ws + WS_MRG, A.ws + WS_WOT, T, D, D, F.G, (int)blockIdx.x);
    EpiP7 E{A.in[0], (const float*)(A.ws + WS_MOD), (float*)(A.ws + WS_X1)};
    pg8::gemm_phase<EpiP7, DenseOrder>(F.lds, D, S, E);
}
constexpr size_t WS_TE = WS_SEG + 1024;
constexpr int R_SS = 0, R_PL = 1024, R_LG = R_PL + 8 * 4096, R_SEL = R_LG + 4096, R_HIST = R_SEL + 1024, R_END = R_HIST + 128;
static_assert(R_END <= RING_BYTES, "router LDS map");
__device__ __forceinline__ void p8_phase(const Args& A, const Frame& F) {
    LAS unsigned char* lds = F.lds;
    const int tid = (int)threadIdx.x, lane = tid & 63, w = F.wave, fr = lane & 15, kq = lane >> 4;
    const float* mod = (const float*)(A.ws + WS_MOD);
    const float* X1 = (const float*)(A.ws + WS_X1);
    bf16* H2 = (bf16*)(A.ws + WS_H2);
    const bf16* RW = (const bf16*)(A.ws + WS_RWT);
    if (tid < 32) *(LAS int*)(lds + R_HIST + tid * 4) = 0;
    for (int tile = blockIdx.x; tile < T / 32; tile += F.G) {
        const int t0 = tile * 32, b = t0 / SEQ, c0 = 128 * w + 8 * kq;
        f32x4 xv[2][4][2];
#pragma unroll
        for (int mb = 0; mb < 2; ++mb)
#pragma unroll
            for (int kk = 0; kk < 4; ++kk) { const GAS f32x4* xp = (const GAS f32x4*)(X1 + (size_t)(t0 + 16 * mb + fr) * D + c0 + 32 * kk); xv[mb][kk][0] = xp[0]; xv[mb][kk][1] = xp[1]; }
#pragma unroll
        for (int mb = 0; mb < 2; ++mb) { float s = 0.f;
#pragma unroll
            for (int kk = 0; kk < 4; ++kk)
#pragma unroll
                for (int h = 0; h < 2; ++h) { const f32x4 v = xv[mb][kk][h]; s += (v.x * v.x + v.y * v.y) + (v.z * v.z + v.w * v.w); }
            s += __shfl_xor(s, 16); s += __shfl_xor(s, 32);
            if (kq == 0) *(LAS float*)(lds + R_SS + (w * 32 + 16 * mb + fr) * 4) = s; }
        LDS_WAIT(); __syncthreads();
        float rr[2];
#pragma unroll
        for (int mb = 0; mb < 2; ++mb) { float s = 0.f;
#pragma unroll
            for (int q = 0; q < 8; ++q) s += *(const LAS float*)(lds + R_SS + (q * 32 + 16 * mb + fr) * 4);
            rr[mb] = rsqrtf(s * (1.f / D) + EPS); }
        f32x4 acc[2][2];
#pragma unroll
        for (int mb = 0; mb < 2; ++mb)
#pragma unroll
            for (int nb = 0; nb < 2; ++nb) acc[mb][nb] = (f32x4){0.f, 0.f, 0.f, 0.f};
        const float* mb_ = mod + b * (NMOD * D);
#pragma unroll
        for (int kk = 0; kk < 4; ++kk) { const int col = c0 + 32 * kk;
            f32x4 gg[2], sh[2], sc[2];
#pragma unroll
            for (int h = 0; h < 2; ++h) { gg[h] = *(const GAS f32x4*)(A.in[23] + col + 4 * h); sh[h] = *(const GAS f32x4*)(mb_ + 3 * D + col + 4 * h); sc[h] = *(const GAS f32x4*)(mb_ + 4 * D + col + 4 * h); }
            bf16x8 wh[2], wl[2];
#pragma unroll
            for (int nb = 0; nb < 2; ++nb) { wh[nb] = *(const GAS bf16x8*)(RW + (size_t)(16 * nb + fr) * D + col); wl[nb] = *(const GAS bf16x8*)(RW + (size_t)NE * D + (size_t)(16 * nb + fr) * D + col); }
#pragma unroll
            for (int mb = 0; mb < 2; ++mb) { unsigned hi[4], lo[4];
#pragma unroll
                for (int h = 0; h < 2; ++h) { const f32x4 o = xv[mb][kk][h] * rr[mb] * gg[h] * (sc[h] + 1.f) + sh[h];
                    const unsigned h0 = f2bf(o.x), h1 = f2bf(o.y), h2_ = f2bf(o.z), h3 = f2bf(o.w);
                    hi[2 * h] = h0 | (h1 << 16); hi[2 * h + 1] = h2_ | (h3 << 16);
                    lo[2 * h] = pk2(o.x - bf2f((unsigned short)h0), o.y - bf2f((unsigned short)h1)); lo[2 * h + 1] = pk2(o.z - bf2f((unsigned short)h2_), o.w - bf2f((unsigned short)h3)); }
                const v4u hv = (v4u){hi[0], hi[1], hi[2], hi[3]}, lv = (v4u){lo[0], lo[1], lo[2], lo[3]};
                *(GAS v4u*)(H2 + (size_t)(t0 + 16 * mb + fr) * D + col) = hv;
                const bf16x8 hh = __builtin_bit_cast(bf16x8, hv), hl = __builtin_bit_cast(bf16x8, lv);
#pragma unroll
                for (int nb = 0; nb < 2; ++nb) { acc[mb][nb] = __builtin_amdgcn_mfma_f32_16x16x32_bf16(wh[nb], hh, acc[mb][nb], 0, 0, 0);
                    acc[mb][nb] = __builtin_amdgcn_mfma_f32_16x16x32_bf16(wh[nb], hl, acc[mb][nb], 0, 0, 0);
                    acc[mb][nb] = __builtin_amdgcn_mfma_f32_16x16x32_bf16(wl[nb], hh, acc[mb][nb], 0, 0, 0); } } }
#pragma unroll
        for (int mb = 0; mb < 2; ++mb)
#pragma unroll
            for (int nb = 0; nb < 2; ++nb) *(LAS f32x4*)(lds + R_PL + w * 4096 + (16 * mb + fr) * 128 + (16 * nb + 4 * kq) * 4) = acc[mb][nb];
        LDS_WAIT(); __syncthreads();
        { const int t = tid >> 4, e = tid & 15; float l0 = A.in[25][e], l1 = A.in[25][e + 16];
#pragma unroll
          for (int q = 0; q < 8; ++q) { l0 += *(const LAS float*)(lds + R_PL + q * 4096 + t * 128 + e * 4); l1 += *(const LAS float*)(lds + R_PL + q * 4096 + t * 128 + (e + 16) * 4); }
          *(LAS float*)(lds + R_LG + t * 128 + e * 4) = l0; *(LAS float*)(lds + R_LG + t * 128 + (e + 16) * 4) = l1;
          LDS_WAIT(); __syncthreads();
          int r0 = 0, r1 = 0;
#pragma unroll
          for (int j = 0; j < NE; ++j) { const float x = *(const LAS float*)(lds + R_LG + t * 128 + j * 4);
              r0 += (x > l0 || (x == l0 && j < e)) ? 1 : 0; r1 += (x > l1 || (x == l1 && j < e + 16)) ? 1 : 0; }
          if (r0 < 4) { *(LAS int*)(lds + R_SEL + (t * 8 + r0) * 4) = e; *(LAS float*)(lds + R_SEL + (t * 8 + 4 + r0) * 4) = l0; }
          if (r1 < 4) { *(LAS int*)(lds + R_SEL + (t * 8 + r1) * 4) = e + 16; *(LAS float*)(lds + R_SEL + (t * 8 + 4 + r1) * 4) = l1; }
          LDS_WAIT(); __syncthreads();
          if (e == 0) { const v4i idx = *(const LAS v4i*)(lds + R_SEL + t * 32); const f32x4 val = *(const LAS f32x4*)(lds + R_SEL + t * 32 + 16);
              const float e1 = __expf(val[1] - val[0]), e2 = __expf(val[2] - val[0]), e3 = __expf(val[3] - val[0]), inv = 1.f / (1.f + e1 + e2 + e3);
              *(GAS v4i*)((int*)(A.ws + WS_TOPI) + (t0 + t) * 4) = idx;
              *(GAS f32x4*)((float*)(A.ws + WS_TOPW) + (t0 + t) * 4) = (f32x4){inv, e1 * inv, e2 * inv, e3 * inv};
#pragma unroll
              for (int k = 0; k < 4; ++k) __hip_atomic_fetch_add((LAS int*)(lds + R_HIST + idx[k] * 4), 1, __ATOMIC_RELAXED, __HIP_MEMORY_SCOPE_WORKGROUP); } }
        LDS_WAIT(); __syncthreads();
    }
    if (tid < 32) ((int*)(A.ws + WS_ROUTE))[blockIdx.x * NE + tid] = *(LAS int*)(lds + R_HIST + tid * 4);
}

__device__ __forceinline__ void p9_phase(const Args& A, const Frame& F) {
    LAS int* li = (LAS int*)F.lds;
    const int tid = ((int)threadIdx.x), lane = ((int)threadIdx.x & 63), me = blockIdx.x;
    const int* blk = (const int*)(A.ws + WS_ROUTE);
    { const int j = tid >> 5, e = tid & 31; int tot = 0, bef = 0;
      for (int b = j; b < F.G; b += 16) { const int c = blk[b * NE + e]; tot += c; bef += (b < me) ? c : 0; }
      li[j * 32 + e] = tot; li[512 + j * 32 + e] = bef; }
    __syncthreads();
    if (tid < 32) { int tot = 0, bef = 0; for (int j = 0; j < 16; ++j) { tot += li[j * 32 + tid]; bef += li[512 + j * 32 + tid]; } li[1024 + tid] = tot; li[1056 + tid] = bef; li[1152 + tid] = 0; }
    __syncthreads();
    if (tid == 0) { int a = 0; for (int e = 0; e < NE; ++e) { li[1088 + e] = a; a += (li[1024 + e] + 255) / 256 * 256; } li[1088 + NE] = a; }
    __syncthreads();
    int* srow = (int*)(A.ws + WS_SROW); int* pos_of = (int*)(A.ws + WS_POS); const int* topi = (const int*)(A.ws + WS_TOPI);
    if (F.wave == 0) {
        for (int tile2 = 2 * me; tile2 < T / 16; tile2 += ((tile2 & 1) ? 2 * F.G - 1 : 1)) {
            const int t = tile2 * 16 + (lane >> 2), ex = topi[t * 4 + (lane & 3)];
            int rank = 0, cnt_mine = 0;
            for (int e = 0; e < NE; ++e) { const unsigned long long m = __ballot(ex == e); if (ex == e) rank = __popcll(m & ((1ull << lane) - 1ull)); if (lane == e) cnt_mine = __popcll(m); }
            const int pos = li[1088 + ex] + li[1056 + ex] + li[1152 + ex] + rank;
            pos_of[t * 4 + (lane & 3)] = pos; srow[pos] = t;
            asm volatile("s_waitcnt lgkmcnt(0)" ::: "memory");
            if (lane < 32) li[1152 + lane] += cnt_mine;
            asm volatile("s_waitcnt lgkmcnt(0)" ::: "memory");
        }
    }
    for (int e = me; e < NE; e += F.G) { const int p0 = li[1088 + e] + li[1024 + e], p1 = li[1088 + e + 1]; for (int r = p0 + tid; r < p1; r += NTHREADS) srow[r] = 0; }
    if (me == 0) { if (tid <= NE) ((int*)(A.ws + WS_SEG))[tid] = li[1088 + tid];
        const int nt = li[1088 + NE] / 256; for (int r = tid; r < nt; r += NTHREADS) { int e = 0; for (int j = 1; j < NE; ++j) e = (r * 256 >= li[1088 + j]) ? j : e; ((int*)(A.ws + WS_TE))[r] = e; } }
    __syncthreads();
}

struct MoeOrder1 {
    const char* H2; const char* W1T; const int* srow; const int* te; int NT, G, c;
    __device__ __forceinline__ bool next(int i, pg8::Unit& u) const {
        const int L = i * G + c, rt = L >> 3, ct = L & 7; if (rt >= NT) return false;
        const int e = te[rt]; u.pm = rt; u.pn = ct; u.aux = e; u.abase = H2;
        u.b0 = W1T + ((size_t)e * 2 * DE + ct * 128) * D * 2; u.b1 = u.b0 + (size_t)DE * D * 2; return true;
    }
    static constexpr bool GATHER = true;
    __device__ __forceinline__ void aoff(const pg8::Unit& u, const int (&R)[2], const int (&C)[2], unsigned (&va)[2][2]) const {
#pragma unroll
        for (int h = 0; h < 2; ++h)
#pragma unroll
            for (int i = 0; i < 2; ++i) va[h][i] = (unsigned)(srow[u.pm * 256 + h * 128 + R[i]] * D + C[i]) * 2u;
    }
};
struct EpiSwiglu {
    static constexpr bool PERM = true;
    const float* b_in; bf16* ACT;
    __device__ __forceinline__ void operator()(const pg8::f32x4 (&acc)[2][2][4][2], const pg8::Unit& u, int wr, int wc, int fr, int fq) const {
        const int row0 = u.pm * 256 + wr * 64 + fr, col = u.pn * 128 + wc * 32 + 8 * fq;
        const float* bi = b_in + (size_t)u.aux * 2 * DE + col;
        const f32x4 bg0 = *(const GAS f32x4*)bi, bg1 = *(const GAS f32x4*)(bi + 4), bu0 = *(const GAS f32x4*)(bi + DE), bu1 = *(const GAS f32x4*)(bi + DE + 4);
#pragma unroll
        for (int ai = 0; ai < 2; ++ai)
#pragma unroll
            for (int m = 0; m < 4; ++m) { float o[8];
#pragma unroll
                for (int j = 0; j < 8; ++j) { const float gt = fminf(acc[ai][0][m][j >> 2][j & 3] + (j < 4 ? bg0[j & 3] : bg1[j & 3]), 7.f);
                    const float up = fminf(fmaxf(acc[ai][1][m][j >> 2][j & 3] + (j < 4 ? bu0[j & 3] : bu1[j & 3]), -7.f), 7.f);
                    o[j] = (up + 1.f) * (gt * sigm(1.702f * gt)); }
                *(GAS v4u*)(ACT + (size_t)(row0 + ai * 128 + m * 16) * DE + col) = (v4u){pk2(o[0], o[1]), pk2(o[2], o[3]), pk2(o[4], o[5]), pk2(o[6], o[7])}; }
    }
};
__device__ __forceinline__ void p10_phase(const Args& A, const Frame& F) {
    const int NT = ((const int*)(A.ws + WS_SEG))[NE] / 256;
    MoeOrder1 S{(const char*)(A.ws + WS_H2), (const char*)(A.ws + WS_W1T), (const int*)(A.ws + WS_SROW), (const int*)(A.ws + WS_TE), NT, F.G, F.vcu};
    EpiSwiglu E{A.in[27], (bf16*)(A.ws + WS_RX)};
    pg8::gemm_phase<EpiSwiglu, MoeOrder1>(F.lds, D, S, E);
}
struct MoeOrder2 {
    const char* ACT; const char* W2T; const int* te; int NT, G, c;
    __device__ __forceinline__ bool next(int i, pg8::Unit& u) const {
        const int L = i * G + c, rt = L >> 2, ct = L & 3; if (rt >= NT) return false;
        const int e = te[rt]; u.pm = rt; u.pn = ct; u.aux = e; u.abase = ACT + (size_t)rt * 256 * DE * 2;
        u.b0 = W2T + ((size_t)e * D + ct * 256) * DE * 2; u.b1 = u.b0 + (size_t)128 * DE * 2; return true;
    }
    static constexpr bool GATHER = false;
    __device__ __forceinline__ void aoff(const pg8::Unit&, const int (&R)[2], const int (&C)[2], unsigned (&va)[2][2]) const {
#pragma unroll
        for (int h = 0; h < 2; ++h)
#pragma unroll
            for (int i = 0; i < 2; ++i) va[h][i] = (unsigned)((h * 128 + R[i]) * DE + C[i]) * 2u;
    }
};
struct EpiMoe2 {
    static constexpr bool PERM = true;
    const float* b_out; bf16* YS;
    __device__ __forceinline__ void operator()(const pg8::f32x4 (&acc)[2][2][4][2], const pg8::Unit& u, int wr, int wc, int fr, int fq) const {
        const int row0 = u.pm * 256 + wr * 64 + fr, col0 = u.pn * 256 + wc * 32 + 8 * fq;
#pragma unroll
        for (int bj = 0; bj < 2; ++bj) { const int col = col0 + bj * 128; const float* bo = b_out + (size_t)u.aux * D + col;
            const f32x4 b0 = *(const GAS f32x4*)bo, b1 = *(const GAS f32x4*)(bo + 4);
#pragma unroll
            for (int ai = 0; ai < 2; ++ai)
#pragma unroll
                for (int m = 0; m < 4; ++m) { const pg8::f32x4 a0 = acc[ai][bj][m][0] + b0, a1 = acc[ai][bj][m][1] + b1;
                    *(GAS v4u*)(YS + (size_t)(row0 + ai * 128 + m * 16) * D + col) = (v4u){pk2(a0[0], a0[1]), pk2(a0[2], a0[3]), pk2(a1[0], a1[1]), pk2(a1[2], a1[3])}; } }
    }
};
__device__ __forceinline__ void p11_phase(const Args& A, const Frame& F) {
    const int NT = ((const int*)(A.ws + WS_SEG))[NE] / 256;
    MoeOrder2 S{(const char*)(A.ws + WS_RX), (const char*)(A.ws + WS_W2T), (const int*)(A.ws + WS_TE), NT, F.G, F.vcu};
    EpiMoe2 E{A.in[29], (bf16*)(A.ws + WS_RY)};
    pg8::gemm_phase<EpiMoe2, MoeOrder2>(F.lds, DE, S, E);
}
__device__ __forceinline__ void p12_phase(const Args& A, const Frame& F) {
    const int gw = F.vcu * NWAVES + F.wave, NGW = F.G * NWAVES, lane = ((int)threadIdx.x & 63);
    const float* mod = (const float*)(A.ws + WS_MOD); const float* X1 = (const float*)(A.ws + WS_X1); const bf16* YS = (const bf16*)(A.ws + WS_RY);
    for (int t = gw; t < T; t += NGW) { const int b = t / SEQ;
        const v4i ps = *(const GAS v4i*)((const int*)(A.ws + WS_POS) + t * 4); const f32x4 wt = *(const GAS f32x4*)((const float*)(A.ws + WS_TOPW) + t * 4);
        const int pp[4] = {ps.x, ps.y, ps.z, ps.w};
        f32x4 o[4]; float s = 0.f;
#pragma unroll
        for (int j = 0; j < 4; ++j) { f32x4 m = {0.f, 0.f, 0.f, 0.f};
#pragma unroll
            for (int k = 0; k < 4; ++k) { const v2u y = ((const GAS v2u*)(YS + (size_t)pp[k] * D))[lane + 64 * j]; const float wk = wt[k];
                m[0] += wk * bflo(y.x); m[1] += wk * bfhi(y.x); m[2] += wk * bflo(y.y); m[3] += wk * bfhi(y.y); }
            const f32x4 xv = ((const GAS f32x4*)(X1 + (size_t)t * D))[lane + 64 * j], g2 = ((const GAS f32x4*)(mod + b * (NMOD * D) + 5 * D))[lane + 64 * j];
            o[j] = xv + g2 * m; s += (o[j].x * o[j].x + o[j].y * o[j].y) + (o[j].z * o[j].z + o[j].w * o[j].w); }
        const float r = rsqrtf(wave_sum(s) * (1.f / D) + EPS);
#pragma unroll
        for (int j = 0; j < 4; ++j) { const f32x4 fg = ((const GAS f32x4*)A.in[30])[lane + 64 * j]; ((GAS f32x4*)(A.out + (size_t)t * D))[lane + 64 * j] = o[j] * r * fg; }
    }
}
constexpr int NPHASE = 13;
__global__ void __launch_bounds__(NTHREADS, 2) mega(Args args) {
    extern __shared__ __attribute__((aligned(16))) unsigned char lds_[];
    Frame F;
    F.lds = (LAS unsigned char*)lds_;
    F.wave = __builtin_amdgcn_readfirstlane((int)threadIdx.x >> 6);
    F.G = gridDim.x; { const int bx = blockIdx.x; F.vcu = (F.G % 8 == 0) ? (bx % 8) * (F.G / 8) + bx / 8 : bx; }
    for (int u = threadIdx.x; u < (LDS_BYTES - LDSCTL_OFF) / 4; u += NTHREADS) ((LAS unsigned*)(F.lds + LDSCTL_OFF))[u] = 0u;
    __syncthreads();
    XcdBarrier bar = xcd_barrier_post((unsigned*)(args.ws + WS_CTL) + CW_BAR, (volatile LAS unsigned*)(F.lds + MISC_OFF) + 8);
    const int lo = args.ph_lo, hi = args.ph_hi;
#define IN(k) (lo <= (k) && (k) < hi)
#define SEAM(k) do { if (IN(k) && IN((k) + 1)) xcd_barrier(bar); } while (0)
    if (IN(0)) { p0_prologue(args, F); } SEAM(0);
    if (IN(1)) { p1_h1(args, F); } SEAM(1);
    if (IN(2)) { p2_proj(args, F); } SEAM(2);
    if (IN(3)) { p3_phase(args, F); } SEAM(3);
    if (IN(4)) { p4_phase(args, F); } SEAM(4);
    if (IN(5)) { p5_phase(args, F); } SEAM(5);
    if (IN(6)) { p6_phase(args, F); } SEAM(6);
    if (IN(7)) { p7_phase(args, F); } SEAM(7);
    if (IN(8)) { p8_phase(args, F); } SEAM(8);
    if (IN(9)) { p9_phase(args, F); } SEAM(9);
    if (IN(10)) { p10_phase(args, F); } SEAM(10);
    if (IN(11)) { p11_phase(args, F); } SEAM(11);
    if (IN(12)) { p12_phase(args, F); }
#undef IN
#undef SEAM
}
}
namespace nv {

__device__ __forceinline__ float sigmoidf_(float x) { return 1.f / (1.f + __expf(-x)); }
__device__ __forceinline__ float gelu_tanh(float x) { const float u = 0.7978845608028654f * (x + 0.044715f * x * x * x); return 0.5f * x * (1.f + tanhf(u)); }

__device__ __forceinline__ float block_sum_256(float v, float* sm) {
#pragma unroll
    for (int o = 32; o > 0; o >>= 1) v += __shfl_xor(v, o);
    __syncthreads();
    if ((threadIdx.x & 63) == 0) sm[threadIdx.x >> 6] = v;
    __syncthreads();
    return sm[0] + sm[1] + sm[2] + sm[3];
}

__global__ void k_mod(const float* __restrict__ c, const float* __restrict__ ada_w, const float* __restrict__ ada_b, float* __restrict__ mod) {
    const int j = blockIdx.x * blockDim.x + threadIdx.x, b = blockIdx.y;
    float acc = ada_b[j];
    for (int k = 0; k < D; ++k) { const float cv = c[b * D + k]; acc += cv * sigmoidf_(cv) * ada_w[(size_t)k * (NMOD * D) + j]; }
    mod[b * (NMOD * D) + j] = acc;
}

__global__ void k_norm_mod(const float* __restrict__ x, const float* __restrict__ g, const float* __restrict__ mod, int shift_off, int scale_off, float* __restrict__ h) {
    __shared__ float sm[8];
    const int t = blockIdx.x, b = t / SEQ;
    const float4 v = ((const float4*)(x + (size_t)t * D))[threadIdx.x];
    const float ss = block_sum_256(v.x * v.x + v.y * v.y + v.z * v.z + v.w * v.w, sm);
    const float r = rsqrtf(ss * (1.f / D) + EPS);
    const int d0 = threadIdx.x * 4;
    const float* mb = mod + b * (NMOD * D);
    float o[4] = {v.x, v.y, v.z, v.w};
#pragma unroll
    for (int i = 0; i < 4; ++i) o[i] = o[i] * r * g[d0 + i] * (1.f + mb[scale_off + d0 + i]) + mb[shift_off + d0 + i];
    ((float4*)(h + (size_t)t * D))[threadIdx.x] = make_float4(o[0], o[1], o[2], o[3]);
}

template <bool DUAL, class AF, class EF>
__device__ __forceinline__ void sgemm_tile(int m0, int n0, int K, const float* __restrict__ Bm, int ldb, int dual_off, AF af, EF ef) {
    __shared__ float As[16][68], Bs[16][68], Bs2[DUAL ? 16 : 1][68];
    const int tid = threadIdx.x, tx = tid & 15, ty = tid >> 4;
    float acc[4][4], acc2[4][4];
#pragma unroll
    for (int i = 0; i < 4; ++i)
#pragma unroll
        for (int j = 0; j < 4; ++j) { acc[i][j] = 0.f; acc2[i][j] = 0.f; }
    for (int k0 = 0; k0 < K; k0 += 16) {
#pragma unroll
        for (int q = 0; q < 4; ++q) { const int idx = tid + q * 256, m = idx >> 4, k = idx & 15; As[k][m] = af(m0 + m, k0 + k); }
#pragma unroll
        for (int q = 0; q < 4; ++q) { const int idx = tid + q * 256, k = idx >> 6, n = idx & 63; Bs[k][n] = Bm[(size_t)(k0 + k) * ldb + n0 + n];
            if (DUAL) Bs2[k][n] = Bm[(size_t)(k0 + k) * ldb + n0 + n + dual_off]; }
        __syncthreads();
#pragma unroll
        for (int k = 0; k < 16; ++k) {
            float a[4], b[4], b2[4];
#pragma unroll
            for (int i = 0; i < 4; ++i) a[i] = As[k][ty * 4 + i];
#pragma unroll
            for (int j = 0; j < 4; ++j) { b[j] = Bs[k][tx * 4 + j]; b2[j] = DUAL ? Bs2[k][tx * 4 + j] : 0.f; }
#pragma unroll
            for (int i = 0; i < 4; ++i)
#pragma unroll
                for (int j = 0; j < 4; ++j) { acc[i][j] += a[i] * b[j]; if (DUAL) acc2[i][j] += a[i] * b2[j]; }
        }
        __syncthreads();
    }
#pragma unroll
    for (int i = 0; i < 4; ++i)
#pragma unroll
        for (int j = 0; j < 4; ++j) ef(m0 + ty * 4 + i, n0 + tx * 4 + j, acc[i][j], acc2[i][j]);
}

__global__ void k_gemm_plain(const float* __restrict__ A, int lda, const float* __restrict__ Bm, int ldb, float* __restrict__ C, int ldc, int K) {
    const int m0 = blockIdx.y * 64, n0 = blockIdx.x * 64;
    sgemm_tile<false>(m0, n0, K, Bm, ldb, 0, [&](int m, int k) { return A[(size_t)m * lda + k]; },
                      [&](int m, int n, float a, float) { C[(size_t)m * ldc + n] = a; });
}
__global__ void k_gemm_glu(const float* __restrict__ Z, const float* __restrict__ W, const float* __restrict__ bias, float* __restrict__ O) {
    const int m0 = blockIdx.y * 64, n0 = blockIdx.x * 64;
    sgemm_tile<false>(m0, n0, SW, W, SW, 0, [&](int m, int k) { return Z[(size_t)m * SW + k]; },
                      [&](int m, int n, float a, float) { O[(size_t)m * SW + n] = Z[(size_t)m * SW + n] * sigmoidf_(a + bias[n]); });
}
template <bool PRE> __global__ void k_gemm_branch(const float* __restrict__ A, const float* __restrict__ W, const float* __restrict__ proj, int gate_off, float* __restrict__ merged, int accumulate) {
    const int m0 = blockIdx.y * 64, n0 = blockIdx.x * 64;
    sgemm_tile<false>(m0, n0, SW, W, D, 0, [&](int m, int k) { return A[(size_t)m * SW + k]; },
                      [&](int m, int n, float a, float) { const float gv = proj[(size_t)m * PW + gate_off + n]; const float v = (PRE ? gv : sigmoidf_(gv)) * a;
                          float* p = merged + (size_t)m * D + n; *p = accumulate ? (*p + v) : v; });
}
__global__ void k_gemm_out(const float* __restrict__ merged, const float* __restrict__ W, const float* __restrict__ x, const float* __restrict__ mod, float* __restrict__ x1) {
    const int m0 = blockIdx.y * 64, n0 = blockIdx.x * 64;
    sgemm_tile<false>(m0, n0, D, W, D, 0, [&](int m, int k) { return merged[(size_t)m * D + k]; },
                      [&](int m, int n, float a, float) { const int b = m / SEQ; x1[(size_t)m * D + n] = x[(size_t)m * D + n] + mod[b * (NMOD * D) + 2 * D + n] * a; });
}

__global__ void k_s5(const float* __restrict__ proj, const float* __restrict__ a_re, const float* __restrict__ a_im, const float* __restrict__ log_dt,
                     const float* __restrict__ b_re, const float* __restrict__ b_im, const float* __restrict__ c_re, const float* __restrict__ c_im,
                     const float* __restrict__ dskip, float* __restrict__ z) {
    __shared__ float s_re[64], s_im[64], cre[16][65], cim[16][65];
    const int p = threadIdx.x, b = blockIdx.x / NG, g = blockIdx.x % NG;
    const double dt = exp((double)log_dt[g]);
    const double lr = a_re[g * NP + p], li = a_im[g * NP + p];
    const double mag = exp(lr * dt), lbr_d = mag * cos(li * dt), lbi_d = mag * sin(li * dt);
    const double nr = lbr_d - 1.0, ni = lbi_d, den = lr * lr + li * li;
    const double cfr = (nr * lr + ni * li) / den, cfi = (ni * lr - nr * li) / den;
    const float lbr = (float)lbr_d, lbi = (float)lbi_d;
    float bbr[16], bbi[16];
#pragma unroll
    for (int h = 0; h < 16; ++h) { const double br = b_re[(g * NP + p) * NHC + h], bi = b_im[(g * NP + p) * NHC + h];
        bbr[h] = (float)(cfr * br - cfi * bi); bbi[h] = (float)(cfr * bi + cfi * br); }
    for (int i = p; i < 16 * 64; i += 64) { const int ho = i / 64, pp = i % 64; cre[ho][pp] = c_re[(g * NHC + ho) * NP + pp]; cim[ho][pp] = c_im[(g * NHC + ho) * NP + pp]; }
    __syncthreads();
    float sr = 0.f, si = 0.f;
    const float dsk = (p < 16) ? dskip[g * NHC + p] : 0.f;
    for (int s = 0; s < SEQ; ++s) {
        const size_t t = (size_t)b * SEQ + s;
        const float4* up = (const float4*)(proj + t * PW + g * NHC);
        const float4 u0 = up[0], u1 = up[1], u2 = up[2], u3 = up[3];
        const float u[16] = {u0.x, u0.y, u0.z, u0.w, u1.x, u1.y, u1.z, u1.w, u2.x, u2.y, u2.z, u2.w, u3.x, u3.y, u3.z, u3.w};
        float br = 0.f, bi = 0.f;
#pragma unroll
        for (int h = 0; h < 16; ++h) { br += bbr[h] * u[h]; bi += bbi[h] * u[h]; }
        const float nsr = lbr * sr - lbi * si + br, nsi = lbr * si + lbi * sr + bi;
        sr = nsr; si = nsi;
        s_re[p] = sr; s_im[p] = si;
        __syncthreads();
        if (p < 16) {
            float y = 0.f;
            for (int pp = 0; pp < 64; ++pp) y += cre[p][pp] * s_re[pp] - cim[p][pp] * s_im[pp];
            float up_ = 0.f;
#pragma unroll
            for (int h = 0; h < 16; ++h) up_ = (h == p) ? u[h] : up_;
            y += dsk * up_;
            z[t * SW + g * NHC + p] = gelu_tanh(y);
        }
        __syncthreads();
    }
}

template <bool PRE> __global__ void k_gmlp_ln(const float* __restrict__ proj, const float* __restrict__ lng, const float* __restrict__ lnb, float* __restrict__ gu, float* __restrict__ vn) {
    __shared__ float sm[8];
    const int t = blockIdx.x, i0 = threadIdx.x * 2;
    const float* pr = proj + (size_t)t * PW + SW;
    const float a0 = PRE ? pr[i0] : gelu_tanh(pr[i0]), a1 = PRE ? pr[i0 + 1] : gelu_tanh(pr[i0 + 1]);
    const float v0 = PRE ? pr[GW + i0] : gelu_tanh(pr[GW + i0]), v1 = PRE ? pr[GW + i0 + 1] : gelu_tanh(pr[GW + i0 + 1]);
    gu[(size_t)t * GW + i0] = a0; gu[(size_t)t * GW + i0 + 1] = a1;
    const float mu = block_sum_256(v0 + v1, sm) * (1.f / GW);
    const float d0 = v0 - mu, d1 = v1 - mu;
    const float var = block_sum_256(d0 * d0 + d1 * d1, sm) * (1.f / GW);
    const float r = rsqrtf(var + EPS);
    vn[(size_t)t * GW + i0] = d0 * r * lng[i0] + lnb[i0];
    vn[(size_t)t * GW + i0 + 1] = d1 * r * lng[i0 + 1] + lnb[i0 + 1];
}
__global__ void k_gmlp_mix(const float* __restrict__ gu, const float* __restrict__ vn, const float* __restrict__ ws, const float* __restrict__ bs, float* __restrict__ gm) {
    const int blk = blockIdx.x, sub = blk & 31, h = (blk >> 5) & 7, chunk = blk >> 8;
    const int tl = sub * 4 + (threadIdx.x >> 6), c = threadIdx.x & 63;
    const float* w = ws + ((size_t)h * CHUNK + tl) * CHUNK;
    const float* v = vn + (size_t)chunk * CHUNK * GW + h * HD + c;
    float acc = 0.f;
    for (int s = 0; s <= tl; ++s) acc += w[s] * v[(size_t)s * GW];
    const size_t o = ((size_t)chunk * CHUNK + tl) * GW + h * HD + c;
    gm[o] = gu[o] * (acc + bs[h * CHUNK + tl]);
}

__global__ void k_router(const float* __restrict__ x1, const float* __restrict__ g2, const float* __restrict__ mod, const float* __restrict__ rw, const float* __restrict__ rb,
                         float* __restrict__ h2, int* __restrict__ topi, float* __restrict__ topw) {
    __shared__ float sm[8], hs[D], part[8][32], lg[32];
    const int t = blockIdx.x, b = t / SEQ;
    const float4 v = ((const float4*)(x1 + (size_t)t * D))[threadIdx.x];
    const float ss = block_sum_256(v.x * v.x + v.y * v.y + v.z * v.z + v.w * v.w, sm);
    const float r = rsqrtf(ss * (1.f / D) + EPS);
    const int d0 = threadIdx.x * 4;
    const float* mb = mod + b * (NMOD * D);
    float o[4] = {v.x, v.y, v.z, v.w};
#pragma unroll
    for (int i = 0; i < 4; ++i) { o[i] = o[i] * r * g2[d0 + i] * (1.f + mb[4 * D + d0 + i]) + mb[3 * D + d0 + i]; hs[d0 + i] = o[i]; }
    ((float4*)(h2 + (size_t)t * D))[threadIdx.x] = make_float4(o[0], o[1], o[2], o[3]);
    __syncthreads();
    { const int e = threadIdx.x & 31, q = threadIdx.x >> 5; float a = 0.f;
      for (int k = q * 128; k < q * 128 + 128; ++k) a += hs[k] * rw[k * NE + e];
      part[q][e] = a; }
    __syncthreads();
    if (threadIdx.x < 32) { float a = rb[threadIdx.x]; for (int q = 0; q < 8; ++q) a += part[q][threadIdx.x]; lg[threadIdx.x] = a; }
    __syncthreads();
    if (threadIdx.x == 0) {
        int idx[4]; float val[4]; unsigned used = 0u;
        for (int k = 0; k < 4; ++k) { int bi = -1; float bv = -INFINITY; for (int e = 0; e < NE; ++e) if (!((used >> e) & 1u) && lg[e] > bv) { bv = lg[e]; bi = e; } used |= 1u << bi; idx[k] = bi; val[k] = bv; }
        float den = 0.f, ex[4];
        for (int k = 0; k < 4; ++k) { ex[k] = __expf(val[k] - val[0]); den += ex[k]; }
        for (int k = 0; k < 4; ++k) { topi[t * 4 + k] = idx[k]; topw[t * 4 + k] = ex[k] / den; }
    }
}

__global__ void k_route(const int* __restrict__ topi, const float* __restrict__ topw, int* __restrict__ seg, int* __restrict__ srow_tok, float* __restrict__ srow_w, int* __restrict__ pos_of) {
    __shared__ int cnt[NE], st[NE + 1];
    const int e = threadIdx.x;
    int c = 0;
    for (int i = 0; i < T * TOPK; ++i) c += (topi[i] == e);
    cnt[e] = c;
    __syncthreads();
    if (e == 0) { int a = 0; for (int j = 0; j < NE; ++j) { st[j] = a; a += (cnt[j] + 255) / 256 * 256; } st[NE] = a; }
    __syncthreads();
    seg[e] = st[e]; if (e == 0) seg[NE] = st[NE];
    int pos = st[e];
    for (int i = 0; i < T * TOPK; ++i) if (topi[i] == e) { srow_tok[pos] = i >> 2; srow_w[pos] = topw[i]; pos_of[i] = pos; ++pos; }
}

__device__ __forceinline__ int find_expert(const int* __restrict__ seg, int row) { int e = 0; for (int j = 1; j < NE; ++j) e = (row >= seg[j]) ? j : e; return e; }

__global__ void k_moe1(const float* __restrict__ h2, const int* __restrict__ seg, const int* __restrict__ srow_tok, const float* __restrict__ w_in, const float* __restrict__ b_in, float* __restrict__ act) {
    const int m0 = blockIdx.y * 64, n0 = blockIdx.x * 64;
    if (m0 >= seg[NE]) return;
    const int e = find_expert(seg, m0);
    const float* W = w_in + (size_t)e * D * 2 * DE; const float* bi = b_in + (size_t)e * 2 * DE;
    sgemm_tile<true>(m0, n0, D, W, 2 * DE, DE, [&](int m, int k) { const int tk = srow_tok[m]; return tk >= 0 ? h2[(size_t)tk * D + k] : 0.f; },
                     [&](int m, int n, float ag, float au) { float gt = fminf(ag + bi[n], 7.f); float up = fminf(fmaxf(au + bi[DE + n], -7.f), 7.f);
                         act[(size_t)m * DE + n] = (up + 1.f) * (gt * sigmoidf_(1.702f * gt)); });
}
__global__ void k_moe2(const float* __restrict__ act, const int* __restrict__ seg, const float* __restrict__ srow_w, const float* __restrict__ w_out, const float* __restrict__ b_out, float* __restrict__ ys) {
    const int m0 = blockIdx.y * 64, n0 = blockIdx.x * 64;
    if (m0 >= seg[NE]) return;
    const int e = find_expert(seg, m0);
    const float* W = w_out + (size_t)e * DE * D; const float* bo = b_out + (size_t)e * D;
    sgemm_tile<false>(m0, n0, DE, W, D, 0, [&](int m, int k) { return act[(size_t)m * DE + k]; },
                      [&](int m, int n, float a, float) { ys[(size_t)m * D + n] = (a + bo[n]) * srow_w[m]; });
}
__global__ void k_final(const float* __restrict__ x1, const float* __restrict__ ys, const int* __restrict__ pos_of, const float* __restrict__ mod, const float* __restrict__ fg, float* __restrict__ out) {
    __shared__ float sm[8];
    const int t = blockIdx.x, b = t / SEQ, d0 = threadIdx.x * 4;
    const float4 xv = ((const float4*)(x1 + (size_t)t * D))[threadIdx.x];
    float m[4] = {0.f, 0.f, 0.f, 0.f};
    for (int k = 0; k < 4; ++k) { const float4 y = ((const float4*)(ys + (size_t)pos_of[t * 4 + k] * D))[threadIdx.x]; m[0] += y.x; m[1] += y.y; m[2] += y.z; m[3] += y.w; }
    const float* g2 = mod + b * (NMOD * D) + 5 * D + d0;
    float o[4] = {xv.x + g2[0] * m[0], xv.y + g2[1] * m[1], xv.z + g2[2] * m[2], xv.w + g2[3] * m[3]};
    const float ss = block_sum_256(o[0] * o[0] + o[1] * o[1] + o[2] * o[2] + o[3] * o[3], sm);
    const float r = rsqrtf(ss * (1.f / D) + EPS);
    ((float4*)(out + (size_t)t * D))[threadIdx.x] = make_float4(o[0] * r * fg[d0], o[1] * r * fg[d0 + 1], o[2] * r * fg[d0 + 2], o[3] * r * fg[d0 + 3]);
}

__global__ void k_bf16_to_f32(const unsigned short* __restrict__ s, float* __restrict__ d, size_t n) { for (size_t i = (size_t)blockIdx.x * blockDim.x + threadIdx.x; i < n; i += (size_t)gridDim.x * blockDim.x) d[i] = __builtin_bit_cast(float, (unsigned)s[i] << 16); }
}
#ifndef REP_PHASE
#define REP_PHASE -1
#define REP_PHASE2 -1
#endif
static int launch_mega(const Args& a0, int lo, int hi, hipStream_t stream) {
    static int grid = 0;
    if (grid == 0) {
        int dev = 0, cus = 0, per_cu = 0;
        if (hipGetDevice(&dev) != hipSuccess || hipDeviceGetAttribute(&cus, hipDeviceAttributeMultiprocessorCount, dev) != hipSuccess) { fprintf(stderr, "kernel_launch: device query failed\n"); grid = -1; return -1; }
        if (hipFuncSetAttribute((const void*)mega, hipFuncAttributeMaxDynamicSharedMemorySize, LDS_BYTES) != hipSuccess) { fprintf(stderr, "kernel_launch: hipFuncSetAttribute failed\n"); grid = -1; return -1; }
        if (hipOccupancyMaxActiveBlocksPerMultiprocessor(&per_cu, (const void*)mega, NTHREADS, LDS_BYTES) != hipSuccess || per_cu < 1) { fprintf(stderr, "kernel_launch: occupancy query says %d blocks per CU\n", per_cu); per_cu = 1; }
        (void)hipGetLastError();
        grid = cus;
    }
    if (grid < 0) return -1;
    Args a = a0; a.ph_lo = lo; a.ph_hi = hi; a.rep = -1; a.pad = 0;
    hipLaunchKernelGGL(mega, dim3(grid), dim3(NTHREADS), LDS_BYTES, stream, a);
    return 0;
}

extern "C" void kernel_launch(void* const* d_in, const int* in_sizes, int n_in, void* d_out, int out_size, void* d_ws, size_t ws_size, hipStream_t stream) {
    if (n_in != 31 || ws_size < 1000 * MiB) { fprintf(stderr, "kernel_launch: unexpected inputs (n_in %d, ws %zu)\n", n_in, ws_size); return; }
    Args a{};
    for (int i = 0; i < 31; ++i) a.in[i] = (const float*)d_in[i];
    a.out = (float*)d_out; a.ws = (unsigned char*)d_ws;
    (void)hipMemsetAsync((char*)d_ws + WS_CTL, 0, CTL_ZERO_BYTES, stream);
    char* ws = (char*)d_ws;
    const float* x = a.in[0];
    float* out = (float*)d_out;
    launch_mega(a, 0, NPHASE, stream);
#if REP_PHASE >= 0
    launch_mega(a, REP_PHASE, REP_PHASE2 + 1, stream);
#endif
}
```
